# Optimizing an MI355X kernel written in HIP

```python
import jax, jax.numpy as jnp
from jax import lax
import numpy as np

D_MODEL = 1024
BATCH = 2
SEQ = 8192
DEPTH = 1

D_MIX = D_MODEL
ATT_HEADS = 8
ATT_KV_HEADS = 2
ATT_HEAD_DIM = 64
WINDOW = 128
ATT_BLOCK = 128
GLA_HEADS = 4
GLA_DK = 64
GLA_DV = 128
GLA_GATE_RANK = 16
GLA_TAU = 16.0
GLA_CHUNK = 64
PEER_HEADS = 8
PEER_QDIM = 256
N_KEYS = 128
N_EXPERTS = N_KEYS * N_KEYS
PEER_TOPK = 16
PEER_BLOCK = 128
NORM_EPS = 1e-6

ATT_Q_W = ATT_HEADS * ATT_HEAD_DIM
ATT_KV_W = ATT_KV_HEADS * ATT_HEAD_DIM
GLA_QK_W = GLA_HEADS * GLA_DK
GLA_V_W = GLA_HEADS * GLA_DV
IN_SIZES = (ATT_Q_W, ATT_KV_W, ATT_KV_W, GLA_QK_W, GLA_QK_W, GLA_V_W, GLA_V_W, GLA_GATE_RANK)
IN_WIDTH = sum(IN_SIZES)

kernel_name = "hymba_swa_sink_gla_peer_adaln"


def rms_norm(x, w):
    xf = x.astype(jnp.float32)
    y = xf * lax.rsqrt(jnp.mean(xf * xf, axis=-1, keepdims=True) + NORM_EPS)
    return (y * w.astype(jnp.float32)).astype(x.dtype)


def sliding_window_attention(q, k, v, sinks):
    B, S = q.shape[0], q.shape[1]
    nb = S // ATT_BLOCK
    G = ATT_HEADS // ATT_KV_HEADS
    qb = q.reshape(B, nb, ATT_BLOCK, ATT_KV_HEADS, G, ATT_HEAD_DIM)

    def band(t):
        tb = t.reshape(B, nb, ATT_BLOCK, ATT_KV_HEADS, ATT_HEAD_DIM)
        prev = jnp.pad(tb, ((0, 0), (1, 0), (0, 0), (0, 0), (0, 0)))[:, :-1]
        return jnp.concatenate([prev, tb], axis=2)

    kb, vb = band(k), band(v)
    scores = jnp.einsum('bnqhgd,bnkhd->bnhgqk', qb, kb).astype(jnp.float32) * (ATT_HEAD_DIM ** -0.5)
    blk = jnp.arange(nb)[:, None, None]
    qpos = blk * ATT_BLOCK + jnp.arange(ATT_BLOCK)[None, :, None]
    kpos = (blk - 1) * ATT_BLOCK + jnp.arange(2 * ATT_BLOCK)[None, None, :]
    rel = qpos - kpos
    mask = (rel >= 0) & (rel < WINDOW) & (kpos >= 0)
    scores = jnp.where(mask[None, :, None, None], scores, -jnp.inf)
    sink = sinks.astype(jnp.float32).reshape(ATT_KV_HEADS, G)[None, None, :, :, None, None]
    sink = jnp.broadcast_to(sink, scores.shape[:-1] + (1,))
    probs = jax.nn.softmax(jnp.concatenate([scores, sink], axis=-1), axis=-1)[..., :-1]
    out = jnp.einsum('bnhgqk,bnkhd->bnqhgd', probs.astype(v.dtype), vb)
    return out.reshape(B, S, ATT_Q_W)


def gla_chunked(q, k, v, log_a):
    B, S = q.shape[0], q.shape[1]
    nc = S // GLA_CHUNK

    def chunks(t):
        return t.astype(jnp.float32).reshape(B, nc, GLA_CHUNK, GLA_HEADS, t.shape[-1]).transpose(1, 0, 3, 2, 4)

    qc = chunks(q) * (GLA_DK ** -0.5)
    kc, vc, gc = chunks(k), chunks(v), chunks(log_a)
    causal = jnp.tril(jnp.ones((GLA_CHUNK, GLA_CHUNK), dtype=bool))

    def step(state, inp):
        qt, kt, vt, gt = inp
        b = jnp.cumsum(gt, axis=2)
        inter = jnp.einsum('bhtd,bhde->bhte', qt * jnp.exp(b), state)
        diff = b[:, :, :, None, :] - b[:, :, None, :, :]
        decay = jnp.exp(jnp.where(causal[:, :, None], diff, -jnp.inf))
        att = jnp.einsum('bhtd,bhsd,bhtsd->bhts', qt, kt, decay)
        intra = jnp.einsum('bhts,bhse->bhte', att, vt)
        b_last = b[:, :, -1:, :]
        new_state = jnp.exp(b_last[:, :, 0, :, None]) * state + jnp.einsum(
            'bhsd,bhse->bhde', kt * jnp.exp(b_last - b), vt)
        return new_state, inter + intra

    state0 = jnp.zeros((B, GLA_HEADS, GLA_DK, GLA_DV), jnp.float32)
    _, out = lax.scan(step, state0, (qc, kc, vc, gc))
    return out.transpose(1, 0, 3, 2, 4).reshape(B, S, GLA_HEADS, GLA_DV)


def peer_ffn(h, wq, subkeys, u, v):
    B, S, D = h.shape
    q = (h @ wq).reshape(B, S, PEER_HEADS, 2, PEER_QDIM // 2)
    sub_scores = jnp.einsum('bshpk,hpnk->bshpn', q, subkeys).astype(jnp.float32)
    top_v, top_i = lax.top_k(sub_scores, PEER_TOPK)
    cand = (top_v[..., 0, :, None] + top_v[..., 1, None, :]).reshape(B, S, PEER_HEADS, PEER_TOPK * PEER_TOPK)
    cand_i = (top_i[..., 0, :, None] * N_KEYS + top_i[..., 1, None, :]).reshape(B, S, PEER_HEADS, PEER_TOPK * PEER_TOPK)
    best_v, best_pos = lax.top_k(cand, PEER_TOPK)
    expert = jnp.take_along_axis(cand_i, best_pos, axis=-1)
    gates = jax.nn.softmax(best_v, axis=-1).astype(h.dtype)
    nblk = (B * S) // PEER_BLOCK
    xs = h.reshape(nblk, PEER_BLOCK, D)
    es = expert.reshape(nblk, PEER_BLOCK, PEER_HEADS * PEER_TOPK)
    gs = gates.reshape(nblk, PEER_BLOCK, PEER_HEADS * PEER_TOPK)

    def block(args):
        xb, eb, gb = args
        ub = jnp.take(u, eb, axis=0)
        hid = jax.nn.gelu(jnp.einsum('tkd,td->tk', ub, xb), approximate=False) * gb
        vb = jnp.take(v, eb, axis=0)
        return jnp.einsum('tk,tkd->td', hid, vb)

    return lax.map(block, (xs, es, gs)).reshape(B, S, D)


def setup_inputs(seed: int = 0) -> dict:
    key = jax.random.key(seed)
    ks = jax.random.split(key, 20)
    f32 = jnp.float32
    nrm = lambda k, shape, s: jax.random.normal(k, shape, f32) * s
    L = DEPTH
    return {
        "x": nrm(ks[0], (BATCH, SEQ, D_MODEL), 1.0),
        "c": nrm(ks[1], (BATCH, D_MODEL), 1.0),
        "w_ada": nrm(ks[2], (L, D_MODEL, 6 * D_MODEL), 0.5 * D_MODEL ** -0.5),
        "b_ada": nrm(ks[3], (L, 6 * D_MODEL), 0.02),
        "norm1_w": 1.0 + nrm(ks[4], (L, D_MODEL), 0.02),
        "w_in": nrm(ks[5], (L, D_MODEL, IN_WIDTH), D_MODEL ** -0.5),
        "attn_sinks": nrm(ks[6], (L, ATT_HEADS), 0.5),
        "gla_gate_up": nrm(ks[7], (L, GLA_GATE_RANK, GLA_QK_W), GLA_GATE_RANK ** -0.5),
        "gla_gate_bias": nrm(ks[8], (L, GLA_QK_W), 0.1),
        "gla_norm_w": 1.0 + nrm(ks[9], (L, GLA_DV), 0.02),
        "w_out": nrm(ks[10], (L, D_MIX, D_MODEL), D_MIX ** -0.5),
        "norm2_w": 1.0 + nrm(ks[11], (L, D_MODEL), 0.02),
        "peer_wq": nrm(ks[12], (L, D_MODEL, PEER_HEADS * PEER_QDIM), D_MODEL ** -0.5),
        "peer_subkeys": nrm(ks[13], (L, PEER_HEADS, 2, N_KEYS, PEER_QDIM // 2), (PEER_QDIM // 2) ** -0.5),
        "peer_u": nrm(ks[14], (L, N_EXPERTS, D_MODEL), D_MODEL ** -0.5),
        "peer_v": nrm(ks[15], (L, N_EXPERTS, D_MODEL), (PEER_HEADS * PEER_TOPK) ** -0.5),
        "final_norm_w": 1.0 + nrm(ks[16], (D_MODEL,), 0.02),
    }


def reference(x, c, w_ada, b_ada, norm1_w, w_in, attn_sinks, gla_gate_up, gla_gate_bias, gla_norm_w,
              w_out, norm2_w, peer_wq, peer_subkeys, peer_u, peer_v, final_norm_w):
    B, S, _ = x.shape
    split_points = np.cumsum(np.array(IN_SIZES))[:-1].tolist()
    for l in range(DEPTH):
        mod = jax.nn.silu(c) @ w_ada[l] + b_ada[l]
        shift1, scale1, gate1, shift2, scale2, gate2 = jnp.split(mod[:, None, :], 6, axis=-1)

        h = rms_norm(x, norm1_w[l]) * (1.0 + scale1) + shift1
        proj = h @ w_in[l]
        aq, ak, av, gq, gk, gv, gg, glr = jnp.split(proj, split_points, axis=-1)
        att = sliding_window_attention(
            aq.reshape(B, S, ATT_HEADS, ATT_HEAD_DIM),
            ak.reshape(B, S, ATT_KV_HEADS, ATT_HEAD_DIM),
            av.reshape(B, S, ATT_KV_HEADS, ATT_HEAD_DIM),
            attn_sinks[l])
        log_a = jax.nn.log_sigmoid((glr @ gla_gate_up[l] + gla_gate_bias[l]).astype(jnp.float32)) / GLA_TAU
        go = gla_chunked(
            gq.reshape(B, S, GLA_HEADS, GLA_DK),
            gk.reshape(B, S, GLA_HEADS, GLA_DK),
            gv.reshape(B, S, GLA_HEADS, GLA_DV),
            log_a.reshape(B, S, GLA_HEADS, GLA_DK))
        go = rms_norm(go, gla_norm_w[l]).reshape(B, S, GLA_V_W).astype(x.dtype) * jax.nn.silu(gg)
        mixed = jnp.concatenate([att, go], axis=-1) @ w_out[l]
        x = x + gate1 * mixed

        h2 = rms_norm(x, norm2_w[l]) * (1.0 + scale2) + shift2
        x = x + gate2 * peer_ffn(h2, peer_wq[l], peer_subkeys[l], peer_u[l], peer_v[l])
    return rms_norm(x, final_norm_w)
```

```cpp
#include <hip/hip_runtime.h>
#include <hip/hip_cooperative_groups.h>
#include <stdint.h>
#include <stdio.h>
namespace cg = cooperative_groups;

#ifndef MULTI
#define MULTI 0
#endif

typedef unsigned short bf16_t;
typedef __attribute__((ext_vector_type(8))) short bf16x8;
typedef __attribute__((ext_vector_type(4))) float f32x4;
typedef __attribute__((ext_vector_type(16))) float f32x16;
typedef __attribute__((ext_vector_type(2))) __bf16 bf2_t;
typedef __attribute__((ext_vector_type(2))) float f2_t;

constexpr int T = 16384, DM = 1024, SEQ = 8192;
constexpr int NPROJ = 2432;
constexpr int C_AK = 512, C_AV = 640, C_GQ = 768, C_GK = 1024, C_GV = 1280, C_GG = 1792, C_GLR = 2304;
constexpr float EPS = 1e-6f;
constexpr int SMEM_BYTES = 73728;
constexpr int LDK = 72;

struct Params {
  const float *x, *c, *w_ada, *b_ada, *norm1_w, *w_in, *sinks, *gate_up, *gate_bias, *gla_norm_w,
      *w_out, *norm2_w, *wq, *subkeys, *pu, *pv, *final_w;
  float* out;
  float *modp, *mod;
  bf16_t *w_inT, *w_outT, *wqT, *skb, *ub, *vb, *hA, *proj, *vT, *gvT;
  float *stateT, *gdec, *x1;
  int* ids;
  float* gates;
  unsigned* bar;
};

__device__ __forceinline__ unsigned pack2(float a, float b) {
  f2_t v = {a, b};
  bf2_t r = __builtin_convertvector(v, bf2_t);
  return __builtin_bit_cast(unsigned, r);
}
__device__ __forceinline__ bf16_t f2bf(float a) { return (bf16_t)(pack2(a, 0.f) & 0xffffu); }
__device__ __forceinline__ float bf2f(bf16_t h) { return __uint_as_float(((unsigned)h) << 16); }
__device__ __forceinline__ float bflo(unsigned u) { return __uint_as_float(u << 16); }
__device__ __forceinline__ float bfhi(unsigned u) { return __uint_as_float(u & 0xffff0000u); }
__device__ __forceinline__ f32x16 mfma32(bf16x8 a, bf16x8 b, f32x16 c) {
  return __builtin_amdgcn_mfma_f32_32x32x16_bf16(a, b, c, 0, 0, 0);
}
__device__ __forceinline__ f32x16 zero16() {
  f32x16 z;
#pragma unroll
  for (int i = 0; i < 16; i++) z[i] = 0.f;
  return z;
}
__device__ __forceinline__ int rho(int g, int h) { return (g & 3) + 8 * (g >> 2) + 4 * h; }
__device__ __forceinline__ bf16x8 mk8(unsigned a, unsigned b, unsigned c, unsigned d) {
  uint4 u = make_uint4(a, b, c, d);
  return __builtin_bit_cast(bf16x8, u);
}
__device__ __forceinline__ float dpp_add16(float v) {
  v += __int_as_float(__builtin_amdgcn_update_dpp(0, __float_as_int(v), 0xB1, 0xf, 0xf, true));
  v += __int_as_float(__builtin_amdgcn_update_dpp(0, __float_as_int(v), 0x4E, 0xf, 0xf, true));
  v += __int_as_float(__builtin_amdgcn_update_dpp(0, __float_as_int(v), 0x141, 0xf, 0xf, true));
  v += __int_as_float(__builtin_amdgcn_update_dpp(0, __float_as_int(v), 0x140, 0xf, 0xf, true));
  return v;
}
__device__ __forceinline__ float rdlane(float v, int l) {
  return __int_as_float(__builtin_amdgcn_readlane(__float_as_int(v), l));
}
__device__ __forceinline__ float wave_sum(float v) {
  v = dpp_add16(v);
  float a = rdlane(v, 0), b = rdlane(v, 16), c = rdlane(v, 32), d = rdlane(v, 48);
  return (a + b) + (c + d);
}

__device__ void ph_mod(const Params& p, int item, char* smem) {
  float* sm = (float*)smem;
  int cgp = item % 96, kq = item / 96;
  int tid = threadIdx.x, c4 = tid & 15, kg = tid >> 4;
  int col = cgp * 64 + c4 * 4;
  float a0[4] = {0, 0, 0, 0}, a1[4] = {0, 0, 0, 0};
#pragma unroll 4
  for (int i = 0; i < 16; i++) {
    int k = kq * 256 + kg + 16 * i;
    float4 w = *(const float4*)(p.w_ada + (size_t)k * 6144 + col);
    float c0 = p.c[k], c1 = p.c[1024 + k];
    float s0 = c0 / (1.f + __expf(-c0)), s1 = c1 / (1.f + __expf(-c1));
    a0[0] += s0 * w.x; a0[1] += s0 * w.y; a0[2] += s0 * w.z; a0[3] += s0 * w.w;
    a1[0] += s1 * w.x; a1[1] += s1 * w.y; a1[2] += s1 * w.z; a1[3] += s1 * w.w;
  }
#pragma unroll
  for (int j = 0; j < 4; j++) {
    sm[kg * 128 + c4 * 4 + j] = a0[j];
    sm[kg * 128 + 64 + c4 * 4 + j] = a1[j];
  }
  __syncthreads();
  if (tid < 128) {
    float s = 0.f;
#pragma unroll
    for (int g = 0; g < 16; g++) s += sm[g * 128 + tid];
    int b = tid >> 6, cc = tid & 63;
    p.modp[(kq * 2 + b) * 6144 + cgp * 64 + cc] = s;
  }
  __syncthreads();
}

__device__ void ph_transpose(const float* __restrict__ W, int N, bf16_t* __restrict__ out, int kt, int nt, char* smem) {
  float* sm = (float*)smem;
  int tid = threadIdx.x;
  int cn = tid & 63, rk = tid >> 6;
  int n = nt * 64 + cn;
#pragma unroll 4
  for (int i = 0; i < 16; i++) {
    int k = rk + 4 * i;
    float v = (n < N) ? W[(size_t)(kt * 64 + k) * N + n] : 0.f;
    sm[k * 65 + cn] = v;
  }
  __syncthreads();
  int nn = tid >> 2, kc = (tid & 3) * 16;
  unsigned pk[8];
#pragma unroll
  for (int j = 0; j < 8; j++) pk[j] = pack2(sm[(kc + 2 * j) * 65 + nn], sm[(kc + 2 * j + 1) * 65 + nn]);
  uint4* dst = (uint4*)(out + (size_t)(nt * 64 + nn) * 1024 + kt * 64 + kc);
  dst[0] = make_uint4(pk[0], pk[1], pk[2], pk[3]);
  dst[1] = make_uint4(pk[4], pk[5], pk[6], pk[7]);
  __syncthreads();
}

__device__ __forceinline__ void ph_convert(const float* __restrict__ src, bf16_t* __restrict__ dst, int item) {
  size_t off = (size_t)item * 2048 + threadIdx.x * 8;
  float4 a = *(const float4*)(src + off), b = *(const float4*)(src + off + 4);
  *(uint4*)(dst + off) = make_uint4(pack2(a.x, a.y), pack2(a.z, a.w), pack2(b.x, b.y), pack2(b.z, b.w));
}

__device__ void phase0(const Params& p, int bid, int nb, char* smem) {
  constexpr int N_MOD = 384, N_TIN = 16 * 38, N_TOUT = 16 * 16, N_TQ = 16 * 32;
  constexpr int N_SK = 128, N_U = 8192;
  constexpr int TOTAL = N_MOD + N_TIN + N_TOUT + N_TQ + N_SK + 2 * N_U;
  for (int it = bid; it < TOTAL; it += nb) {
    int i = it;
    if (i < N_MOD) { ph_mod(p, i, smem); continue; }
    i -= N_MOD;
    if (i < N_TIN) { ph_transpose(p.w_in, 2320, p.w_inT, i & 15, i >> 4, smem); continue; }
    i -= N_TIN;
    if (i < N_TOUT) { ph_transpose(p.w_out, 1024, p.w_outT, i & 15, i >> 4, smem); continue; }
    i -= N_TOUT;
    if (i < N_TQ) { ph_transpose(p.wq, 2048, p.wqT, i & 15, i >> 4, smem); continue; }
    i -= N_TQ;
    if (i < N_SK) { ph_convert(p.subkeys, p.skb, i); continue; }
    i -= N_SK;
    if (i < N_U) { ph_convert(p.pu, p.ub, i); continue; }
    i -= N_U;
    ph_convert(p.pv, p.vb, i);
  }
}

template <bool SECOND>
__device__ void phase_norm(const Params& p, int bid, int nb, char* smem) {
  float* tw = (float*)smem;
  float* ts = tw + 1024;
  const int tid = threadIdx.x, lane = tid & 63, w = tid >> 6;
  const float* src = SECOND ? p.x1 : p.x;
  const float* nw = SECOND ? p.norm2_w : p.norm1_w;
  for (int item = bid; item < 256; item += nb) {
    int b = item >> 7;
    if (!SECOND) {
      if (item < 48) {
        int j = item * 256 + tid;
        int bb = j / 6144, jj = j % 6144;
        float s = p.b_ada[jj];
#pragma unroll
        for (int q = 0; q < 4; q++) s += p.modp[(q * 2 + bb) * 6144 + jj];
        p.mod[j] = s;
      }
      for (int j = tid; j < 1024; j += 256) {
        float sc = p.b_ada[1024 + j], sh = p.b_ada[j];
#pragma unroll
        for (int q = 0; q < 4; q++) {
          sc += p.modp[(q * 2 + b) * 6144 + 1024 + j];
          sh += p.modp[(q * 2 + b) * 6144 + j];
        }
        tw[j] = nw[j] * (1.f + sc);
        ts[j] = sh;
      }
    } else {
      for (int j = tid; j < 1024; j += 256) {
        tw[j] = nw[j] * (1.f + p.mod[b * 6144 + 4 * 1024 + j]);
        ts[j] = p.mod[b * 6144 + 3 * 1024 + j];
      }
    }
    __syncthreads();
    for (int tt = 0; tt < 16; tt++) {
      int tok = item * 64 + w * 16 + tt;
      const float* xr = src + (size_t)tok * 1024;
      float4 v[4];
      float ss = 0.f;
#pragma unroll
      for (int i = 0; i < 4; i++) {
        v[i] = *(const float4*)(xr + lane * 4 + 256 * i);
        ss += v[i].x * v[i].x + v[i].y * v[i].y + v[i].z * v[i].z + v[i].w * v[i].w;
      }
      ss = wave_sum(ss);
      float rstd = rsqrtf(ss * (1.f / 1024.f) + EPS);
#pragma unroll
      for (int i = 0; i < 4; i++) {
        int e = lane * 4 + 256 * i;
        float4 a = *(const float4*)(tw + e), s = *(const float4*)(ts + e);
        float o0 = v[i].x * rstd * a.x + s.x, o1 = v[i].y * rstd * a.y + s.y;
        float o2 = v[i].z * rstd * a.z + s.z, o3 = v[i].w * rstd * a.w + s.w;
        *(uint2*)(p.hA + (size_t)tok * 1024 + e) = make_uint2(pack2(o0, o1), pack2(o2, o3));
      }
    }
    __syncthreads();
  }
}

__device__ __forceinline__ void gemm_mainloop(const bf16_t* __restrict__ Wt, const bf16_t* __restrict__ Xa,
                                              int n0, int t0, char* smem, f32x16 (&acc)[2][2]) {
  const int tid = threadIdx.x, lane = tid & 63, w = tid >> 6, wn = w >> 1, wt = w & 1;
  const int r = lane & 31, h = lane >> 5;
  bf16_t* sW = (bf16_t*)smem;
  bf16_t* sX = sW + 2 * 128 * LDK;
  uint4 rw[4], rx[4];
  const bf16_t* gW = Wt + (size_t)(n0 + (tid >> 3)) * 1024 + (tid & 7) * 8;
  const bf16_t* gX = Xa + (size_t)(t0 + (tid >> 3)) * 1024 + (tid & 7) * 8;
  const int soff = (tid >> 3) * LDK + (tid & 7) * 8;
#pragma unroll
  for (int i = 0; i < 2; i++)
#pragma unroll
    for (int j = 0; j < 2; j++) acc[i][j] = zero16();
#pragma unroll
  for (int i = 0; i < 4; i++) {
    rw[i] = *(const uint4*)(gW + (size_t)i * 32 * 1024);
    rx[i] = *(const uint4*)(gX + (size_t)i * 32 * 1024);
  }
#pragma unroll
  for (int i = 0; i < 4; i++) {
    *(uint4*)(sW + soff + i * 32 * LDK) = rw[i];
    *(uint4*)(sX + soff + i * 32 * LDK) = rx[i];
  }
  __syncthreads();
  for (int kt = 0; kt < 16; kt++) {
    if (kt + 1 < 16) {
#pragma unroll
      for (int i = 0; i < 4; i++) {
        rw[i] = *(const uint4*)(gW + (size_t)i * 32 * 1024 + (kt + 1) * 64);
        rx[i] = *(const uint4*)(gX + (size_t)i * 32 * 1024 + (kt + 1) * 64);
      }
    }
    const bf16_t* bW = sW + (kt & 1) * 128 * LDK + (64 * wn + r) * LDK + h * 8;
    const bf16_t* bX = sX + (kt & 1) * 128 * LDK + (64 * wt + r) * LDK + h * 8;
#pragma unroll
    for (int s = 0; s < 4; s++) {
      bf16x8 aw[2], bx[2];
#pragma unroll
      for (int i = 0; i < 2; i++) aw[i] = *(const bf16x8*)(bW + i * 32 * LDK + s * 16);
#pragma unroll
      for (int j = 0; j < 2; j++) bx[j] = *(const bf16x8*)(bX + j * 32 * LDK + s * 16);
#pragma unroll
      for (int i = 0; i < 2; i++)
#pragma unroll
        for (int j = 0; j < 2; j++) acc[i][j] = mfma32(aw[i], bx[j], acc[i][j]);
    }
    if (kt + 1 < 16) {
      const int bo = ((kt + 1) & 1) * 128 * LDK;
#pragma unroll
      for (int i = 0; i < 4; i++) {
        *(uint4*)(sW + bo + soff + i * 32 * LDK) = rw[i];
        *(uint4*)(sX + bo + soff + i * 32 * LDK) = rx[i];
      }
    }
    __syncthreads();
  }
}

__device__ void phase_inproj(const Params& p, int bid, int nb, char* smem) {
  const int tid = threadIdx.x, lane = tid & 63, w = tid >> 6, wn = w >> 1, wt = w & 1;
  const int r = lane & 31, h = lane >> 5;
  for (int item = bid; item < 19 * 128; item += nb) {
    int ntile = item % 19, ttile = item / 19;
    int n0 = ntile * 128, t0 = ttile * 128;
    f32x16 acc[2][2];
    gemm_mainloop(p.w_inT, p.hA, n0, t0, smem, acc);
    const bool isAV = (ntile == 5), isGV = (ntile >= 10 && ntile < 14);
#pragma unroll
    for (int i = 0; i < 2; i++)
#pragma unroll
      for (int j = 0; j < 2; j++) {
        int tok = t0 + 64 * wt + 32 * j + r;
        if (isAV || isGV) {
          int b = tok >> 13, s = tok & 8191;
#pragma unroll
          for (int g = 0; g < 16; g++) {
            int n = n0 + 64 * wn + 32 * i + rho(g, h);
            bf16_t v = f2bf(acc[i][j][g]);
            if (isAV) p.vT[((size_t)(b * 128 + (n - C_AV))) * SEQ + s] = v;
            else p.gvT[((size_t)(b * 512 + (n - C_GV))) * SEQ + s] = v;
          }
        } else {
#pragma unroll
          for (int gg = 0; gg < 4; gg++) {
            int n = n0 + 64 * wn + 32 * i + 8 * gg + 4 * h;
            *(uint2*)(p.proj + (size_t)tok * NPROJ + n) =
                make_uint2(pack2(acc[i][j][4 * gg], acc[i][j][4 * gg + 1]), pack2(acc[i][j][4 * gg + 2], acc[i][j][4 * gg + 3]));
          }
        }
      }
  }
}

__device__ void ph_attn(const Params& p, int item) {
  const int tid = threadIdx.x, lane = tid & 63, w = tid >> 6, r = lane & 31, h = lane >> 5;
  const int hq = item & 7, nblk = (item >> 3) & 63, b = item >> 9, kvh = hq >> 2;
  const int q_tok = b * SEQ + nblk * 128 + 32 * w + r;
  bf16x8 qf[4];
#pragma unroll
  for (int s = 0; s < 4; s++) qf[s] = *(const bf16x8*)(p.proj + (size_t)q_tok * NPROJ + hq * 64 + s * 16 + h * 8);
  f32x16 sa[5];
#pragma unroll
  for (int tt = 0; tt < 5; tt++) {
    int kpos = (nblk - 1) * 128 + 32 * (w + tt) + r;
    kpos = kpos < 0 ? 0 : kpos;
    const bf16_t* kptr = p.proj + (size_t)(b * SEQ + kpos) * NPROJ + C_AK + kvh * 64 + h * 8;
    sa[tt] = zero16();
#pragma unroll
    for (int s = 0; s < 4; s++) {
      bf16x8 kf = *(const bf16x8*)(kptr + s * 16);
      sa[tt] = mfma32(kf, qf[s], sa[tt]);
    }
  }
  const float L2E = 1.4426950408889634f;
  const float sc = 0.125f * L2E;
  const float sinkt = p.sinks[hq] * L2E;
  float m = sinkt;
#pragma unroll
  for (int tt = 0; tt < 5; tt++)
#pragma unroll
    for (int g = 0; g < 16; g++) {
      int rr = rho(g, h);
      int d = 32 * tt + rr - r;
      bool valid = (d >= 1) && (d <= 128) && (nblk > 0 || (32 * (w + tt) + rr) >= 128);
      float v = valid ? sa[tt][g] * sc : -INFINITY;
      sa[tt][g] = v;
      m = fmaxf(m, v);
    }
  m = fmaxf(m, __shfl_xor(m, 32));
  float sum = 0.f;
#pragma unroll
  for (int tt = 0; tt < 5; tt++)
#pragma unroll
    for (int g = 0; g < 16; g++) {
      float e = exp2f(sa[tt][g] - m);
      sa[tt][g] = e;
      sum += e;
    }
  sum += __shfl_xor(sum, 32);
  sum += exp2f(sinkt - m);
  const float inv = 1.f / sum;
  f32x16 o[2];
  o[0] = zero16(); o[1] = zero16();
#pragma unroll
  for (int tt = 0; tt < 5; tt++)
#pragma unroll
    for (int s2 = 0; s2 < 2; s2++) {
      bf16x8 pf = mk8(pack2(sa[tt][8 * s2 + 0], sa[tt][8 * s2 + 1]), pack2(sa[tt][8 * s2 + 2], sa[tt][8 * s2 + 3]),
                      pack2(sa[tt][8 * s2 + 4], sa[tt][8 * s2 + 5]), pack2(sa[tt][8 * s2 + 6], sa[tt][8 * s2 + 7]));
      int kb = (nblk - 1) * 128 + 32 * (w + tt) + 16 * s2 + 4 * h;
      kb = kb < 0 ? 0 : kb;
#pragma unroll
      for (int mt = 0; mt < 2; mt++) {
        const bf16_t* vp = p.vT + ((size_t)(b * 128 + kvh * 64 + 32 * mt + r)) * SEQ + kb;
        uint2 lo = *(const uint2*)vp, hi = *(const uint2*)(vp + 8);
        o[mt] = mfma32(mk8(lo.x, lo.y, hi.x, hi.y), pf, o[mt]);
      }
    }
#pragma unroll
  for (int mt = 0; mt < 2; mt++)
#pragma unroll
    for (int gg = 0; gg < 4; gg++) {
      int d0 = 32 * mt + 8 * gg + 4 * h;
      *(uint2*)(p.hA + (size_t)q_tok * 1024 + hq * 64 + d0) =
          make_uint2(pack2(o[mt][4 * gg] * inv, o[mt][4 * gg + 1] * inv), pack2(o[mt][4 * gg + 2] * inv, o[mt][4 * gg + 3] * inv));
    }
}

__device__ __forceinline__ void gla_decay(const Params& p, int b, int hh, int c, char* smem, float (&bl)[16], float& blast) {
  float* sglr = (float*)smem;
  float* sgrp = sglr + 1024;
  const int tid = threadIdx.x, d = tid & 63, tq = tid >> 6;
  const int tok0 = b * SEQ + c * 64;
  {
    int idx = tid * 4, t = idx >> 4, rr = idx & 15;
    uint2 u = *(const uint2*)(p.proj + (size_t)(tok0 + t) * NPROJ + C_GLR + rr);
    sglr[idx] = bflo(u.x); sglr[idx + 1] = bfhi(u.x); sglr[idx + 2] = bflo(u.y); sglr[idx + 3] = bfhi(u.y);
  }
  float gu[16];
#pragma unroll
  for (int rr = 0; rr < 16; rr++) gu[rr] = p.gate_up[rr * 256 + hh * 64 + d];
  const float bias = p.gate_bias[hh * 64 + d];
  __syncthreads();
  float run = 0.f;
#pragma unroll
  for (int i = 0; i < 16; i++) {
    int t = tq * 16 + i;
    float z = bias;
#pragma unroll
    for (int q = 0; q < 4; q++) {
      float4 g4 = *(const float4*)(sglr + t * 16 + q * 4);
      z += g4.x * gu[q * 4] + g4.y * gu[q * 4 + 1] + g4.z * gu[q * 4 + 2] + g4.w * gu[q * 4 + 3];
    }
    float la = (fminf(z, 0.f) - __logf(1.f + __expf(-fabsf(z)))) * (1.f / 16.f);
    run += la;
    bl[i] = run;
  }
  sgrp[tq * 64 + d] = run;
  __syncthreads();
  float off = 0.f, tot = 0.f;
#pragma unroll
  for (int q = 0; q < 4; q++) {
    float v = sgrp[q * 64 + d];
    tot += v;
    off += (q < tq) ? v : 0.f;
  }
#pragma unroll
  for (int i = 0; i < 16; i++) bl[i] += off;
  blast = tot;
}

__device__ void ph_gla_a(const Params& p, int item, char* smem) {
  const int tid = threadIdx.x, lane = tid & 63, w = tid >> 6, r = lane & 31, h = lane >> 5;
  const int d = tid & 63, tq = tid >> 6;
  const int c = item & 127, hh = (item >> 7) & 3, b = item >> 9;
  const int tok0 = b * SEQ + c * 64;
  float bl[16], blast;
  gla_decay(p, b, hh, c, smem, bl, blast);
  bf16_t* k2T = (bf16_t*)(smem + 8192);
  unsigned pk[8];
#pragma unroll
  for (int i = 0; i < 8; i++) {
    int t0 = tq * 16 + 2 * i;
    float k0 = bf2f(p.proj[(size_t)(tok0 + t0) * NPROJ + C_GK + hh * 64 + d]);
    float k1 = bf2f(p.proj[(size_t)(tok0 + t0 + 1) * NPROJ + C_GK + hh * 64 + d]);
    pk[i] = pack2(k0 * __expf(blast - bl[2 * i]), k1 * __expf(blast - bl[2 * i + 1]));
  }
  *(uint4*)(k2T + d * LDK + tq * 16) = make_uint4(pk[0], pk[1], pk[2], pk[3]);
  *(uint4*)(k2T + d * LDK + tq * 16 + 8) = make_uint4(pk[4], pk[5], pk[6], pk[7]);
  if (tq == 0) p.gdec[item * 64 + d] = __expf(blast);
  __syncthreads();
  f32x16 acc[2];
  acc[0] = zero16(); acc[1] = zero16();
  const bf16_t* vrow = p.gvT + ((size_t)(b * 512 + hh * 128 + 32 * w + r)) * SEQ + c * 64 + 8 * h;
#pragma unroll
  for (int s = 0; s < 4; s++) {
    bf16x8 av = *(const bf16x8*)(vrow + 16 * s);
#pragma unroll
    for (int nt = 0; nt < 2; nt++) {
      bf16x8 bk = *(const bf16x8*)(k2T + (32 * nt + r) * LDK + 16 * s + 8 * h);
      acc[nt] = mfma32(av, bk, acc[nt]);
    }
  }
  float* st = p.stateT + (size_t)item * 8192;
#pragma unroll
  for (int nt = 0; nt < 2; nt++)
#pragma unroll
    for (int g = 0; g < 16; g++) st[(32 * w + rho(g, h)) * 64 + 32 * nt + r] = acc[nt][g];
  __syncthreads();
}

__device__ void phase_mix_a(const Params& p, int bid, int nb, char* smem) {
  for (int it = bid; it < 2048; it += nb) {
    if (it < 1024) ph_gla_a(p, it, smem);
    else ph_attn(p, it - 1024);
  }
}

__device__ void phase_scan(const Params& p, int bid, int nb) {
  for (int it = bid; it < 256; it += nb) {
    int bh = it >> 5, e = (it & 31) * 256 + threadIdx.x, dk = e & 63;
    float st = 0.f;
    for (int c0 = 0; c0 < 128; c0 += 16) {
      float sl[16], gd[16];
#pragma unroll
      for (int j = 0; j < 16; j++) {
        sl[j] = p.stateT[(size_t)(bh * 128 + c0 + j) * 8192 + e];
        gd[j] = p.gdec[(bh * 128 + c0 + j) * 64 + dk];
      }
#pragma unroll
      for (int j = 0; j < 16; j++) {
        p.stateT[(size_t)(bh * 128 + c0 + j) * 8192 + e] = st;
        st = gd[j] * st + sl[j];
      }
    }
  }
}

__device__ void phase_gla_c(const Params& p, int bid, int nb, char* smem) {
  const int tid = threadIdx.x, lane = tid & 63, w = tid >> 6, r = lane & 31, h = lane >> 5;
  const int d = tid & 63, tq = tid >> 6;
  bf16_t* qs = (bf16_t*)(smem + 8192);
  bf16_t* ks = qs + 64 * LDK;
  float* sred = (float*)(smem + 8192 + 2 * 64 * LDK * 2);
  for (int item = bid; item < 1024; item += nb) {
    const int c = item & 127, hh = (item >> 7) & 3, b = item >> 9;
    const int tok0 = b * SEQ + c * 64;
    float bl[16], blast;
    gla_decay(p, b, hh, c, smem, bl, blast);
#pragma unroll
    for (int i = 0; i < 16; i++) {
      int t = tq * 16 + i;
      const bf16_t* pr = p.proj + (size_t)(tok0 + t) * NPROJ + hh * 64 + d;
      float qv = bf2f(pr[C_GQ]), kv = bf2f(pr[C_GK]);
      qs[t * LDK + d] = f2bf(qv * 0.125f * __expf(bl[i]));
      ks[t * LDK + d] = f2bf(kv * __expf(-bl[i]));
    }
    __syncthreads();
    const int tt = w & 1, dvh = w >> 1;
    f32x16 at[2];
    at[0] = zero16(); at[1] = zero16();
#pragma unroll
    for (int s = 0; s < 4; s++) {
      bf16x8 bq = *(const bf16x8*)(qs + (32 * tt + r) * LDK + 16 * s + 8 * h);
      bf16x8 a0 = *(const bf16x8*)(ks + r * LDK + 16 * s + 8 * h);
      at[0] = mfma32(a0, bq, at[0]);
      if (tt == 1) {
        bf16x8 a1 = *(const bf16x8*)(ks + (32 + r) * LDK + 16 * s + 8 * h);
        at[1] = mfma32(a1, bq, at[1]);
      }
    }
#pragma unroll
    for (int g = 0; g < 16; g++) {
      int rr = rho(g, h);
      if (tt == 0) { if (rr > r) at[0][g] = 0.f; }
      else { if (rr > r) at[1][g] = 0.f; }
    }
    f32x16 o[2];
    o[0] = zero16(); o[1] = zero16();
#pragma unroll
    for (int st = 0; st < 2; st++) {
      if (st <= tt) {
#pragma unroll
        for (int s2 = 0; s2 < 2; s2++) {
          bf16x8 pf = mk8(pack2(at[st][8 * s2 + 0], at[st][8 * s2 + 1]), pack2(at[st][8 * s2 + 2], at[st][8 * s2 + 3]),
                          pack2(at[st][8 * s2 + 4], at[st][8 * s2 + 5]), pack2(at[st][8 * s2 + 6], at[st][8 * s2 + 7]));
#pragma unroll
          for (int m2 = 0; m2 < 2; m2++) {
            int mt = 2 * dvh + m2;
            const bf16_t* vp = p.gvT + ((size_t)(b * 512 + hh * 128 + 32 * mt + r)) * SEQ + c * 64 + 32 * st + 16 * s2 + 4 * h;
            uint2 lo = *(const uint2*)vp, hi = *(const uint2*)(vp + 8);
            o[m2] = mfma32(mk8(lo.x, lo.y, hi.x, hi.y), pf, o[m2]);
          }
        }
      }
    }
    const float* stp = p.stateT + (size_t)item * 8192;
#pragma unroll
    for (int s = 0; s < 4; s++) {
      bf16x8 bq = *(const bf16x8*)(qs + (32 * tt + r) * LDK + 16 * s + 8 * h);
#pragma unroll
      for (int m2 = 0; m2 < 2; m2++) {
        int mt = 2 * dvh + m2;
        const float* sp = stp + (32 * mt + r) * 64 + 16 * s + 8 * h;
        float4 f0 = *(const float4*)sp, f1 = *(const float4*)(sp + 4);
        o[m2] = mfma32(mk8(pack2(f0.x, f0.y), pack2(f0.z, f0.w), pack2(f1.x, f1.y), pack2(f1.z, f1.w)), bq, o[m2]);
      }
    }
    float ss = 0.f;
#pragma unroll
    for (int m2 = 0; m2 < 2; m2++)
#pragma unroll
      for (int g = 0; g < 16; g++) ss += o[m2][g] * o[m2][g];
    ss += __shfl_xor(ss, 32);
    if (h == 0) sred[dvh * 64 + 32 * tt + r] = ss;
    __syncthreads();
    float tot = sred[32 * tt + r] + sred[64 + 32 * tt + r];
    float rstd = rsqrtf(tot * (1.f / 128.f) + EPS);
    const int tok = tok0 + 32 * tt + r;
#pragma unroll
    for (int m2 = 0; m2 < 2; m2++)
#pragma unroll
      for (int gg = 0; gg < 4; gg++) {
        int dv0 = 32 * (2 * dvh + m2) + 8 * gg + 4 * h;
        uint2 gu = *(const uint2*)(p.proj + (size_t)tok * NPROJ + C_GG + hh * 128 + dv0);
        float4 nw = *(const float4*)(p.gla_norm_w + dv0);
        float g0 = bflo(gu.x), g1 = bfhi(gu.x), g2 = bflo(gu.y), g3 = bfhi(gu.y);
        float r0 = o[m2][4 * gg] * rstd * nw.x * (g0 / (1.f + __expf(-g0)));
        float r1 = o[m2][4 * gg + 1] * rstd * nw.y * (g1 / (1.f + __expf(-g1)));
        float r2 = o[m2][4 * gg + 2] * rstd * nw.z * (g2 / (1.f + __expf(-g2)));
        float r3 = o[m2][4 * gg + 3] * rstd * nw.w * (g3 / (1.f + __expf(-g3)));
        *(uint2*)(p.hA + (size_t)tok * 1024 + 512 + hh * 128 + dv0) = make_uint2(pack2(r0, r1), pack2(r2, r3));
      }
    __syncthreads();
  }
}

__device__ void phase_outproj(const Params& p, int bid, int nb, char* smem) {
  const int tid = threadIdx.x, lane = tid & 63, w = tid >> 6, wn = w >> 1, wt = w & 1;
  const int r = lane & 31, h = lane >> 5;
  for (int item = bid; item < 8 * 128; item += nb) {
    int ntile = item & 7, ttile = item >> 3;
    int n0 = ntile * 128, t0 = ttile * 128;
    int b = t0 >> 13;
    f32x16 acc[2][2];
    gemm_mainloop(p.w_outT, p.hA, n0, t0, smem, acc);
    const float* g1 = p.mod + b * 6144 + 2 * 1024;
#pragma unroll
    for (int i = 0; i < 2; i++)
#pragma unroll
      for (int j = 0; j < 2; j++) {
        int tok = t0 + 64 * wt + 32 * j + r;
#pragma unroll
        for (int gg = 0; gg < 4; gg++) {
          int n = n0 + 64 * wn + 32 * i + 8 * gg + 4 * h;
          float4 xv = *(const float4*)(p.x + (size_t)tok * 1024 + n);
          float4 gv = *(const float4*)(g1 + n);
          float4 ov;
          ov.x = xv.x + gv.x * acc[i][j][4 * gg];
          ov.y = xv.y + gv.y * acc[i][j][4 * gg + 1];
          ov.z = xv.z + gv.z * acc[i][j][4 * gg + 2];
          ov.w = xv.w + gv.w * acc[i][j][4 * gg + 3];
          *(float4*)(p.x1 + (size_t)tok * 1024 + n) = ov;
        }
      }
  }
}

__device__ __forceinline__ int fkey(float f) {
  int b = __float_as_int(f);
  return b ^ ((b >> 31) & 0x7fffffff);
}
__device__ __forceinline__ float kfloat(int k) { return __int_as_float(k ^ ((k >> 31) & 0x7fffffff)); }

__device__ __forceinline__ void bitonic_sort16(int (&a)[16]) {
#pragma unroll
  for (int k = 2; k <= 16; k <<= 1) {
#pragma unroll
    for (int j = k >> 1; j > 0; j >>= 1) {
#pragma unroll
      for (int i = 0; i < 16; i++) {
        int l = i ^ j;
        if (l > i) {
          bool up = ((i & k) == 0) || (k == 16);
          int mx = max(a[i], a[l]), mn = min(a[i], a[l]);
          a[i] = up ? mx : mn;
          a[l] = up ? mn : mx;
        }
      }
    }
  }
}
__device__ __forceinline__ void bitonic_merge16(int (&a)[16]) {
#pragma unroll
  for (int j = 8; j > 0; j >>= 1) {
#pragma unroll
    for (int i = 0; i < 16; i++) {
      int l = i ^ j;
      if (l > i) {
        int mx = max(a[i], a[l]), mn = min(a[i], a[l]);
        a[i] = mx; a[l] = mn;
      }
    }
  }
}
__device__ __forceinline__ void merge_top16(int (&a)[16], const int (&b)[16]) {
#pragma unroll
  for (int i = 0; i < 16; i++) a[i] = max(a[i], b[15 - i]);
  bitonic_merge16(a);
}

struct PairTab { int pi[64], pj[64]; };
__host__ __device__ constexpr PairTab make_pairs() {
  PairTab t{};
  int n = 0;
  for (int i = 0; i < 16; i++)
    for (int j = 0; j < 16; j++)
      if ((i + 1) * (j + 1) <= 16) { t.pi[n] = i; t.pj[n] = j; n++; }
  for (; n < 64; n++) { t.pi[n] = -1; t.pj[n] = -1; }
  return t;
}

__device__ void phase_peer_topk(const Params& p, int bid, int nb, char* smem) {
  const int tid = threadIdx.x, lane = tid & 63, w = tid >> 6, wn = w >> 1, wt = w & 1;
  const int r = lane & 31, h = lane >> 5;
  constexpr int LDQ = 136;
  bf16_t* sQ = (bf16_t*)smem;
  int* slst = (int*)(smem + 40960) + w * (32 * 33);
  for (int item = bid; item < 1024; item += nb) {
    const int hh = item & 7, t0 = (item >> 3) * 128;
    int L[2][16];
#pragma unroll
    for (int pp = 0; pp < 2; pp++) {
      f32x16 acc[2][2];
      gemm_mainloop(p.wqT, p.hA, hh * 256 + pp * 128, t0, smem, acc);
#pragma unroll
      for (int i = 0; i < 2; i++)
#pragma unroll
        for (int j = 0; j < 2; j++)
#pragma unroll
          for (int gg = 0; gg < 4; gg++) {
            int tl = 64 * wt + 32 * j + r, qc = 64 * wn + 32 * i + 8 * gg + 4 * h;
            *(uint2*)(sQ + tl * LDQ + qc) =
                make_uint2(pack2(acc[i][j][4 * gg], acc[i][j][4 * gg + 1]), pack2(acc[i][j][4 * gg + 2], acc[i][j][4 * gg + 3]));
          }
      __syncthreads();
      f32x16 sc[4];
#pragma unroll
      for (int m = 0; m < 4; m++) sc[m] = zero16();
      const bf16_t* skp = p.skb + (size_t)((hh * 2 + pp) * 128 + r) * 128 + 8 * h;
#pragma unroll
      for (int s = 0; s < 8; s++) {
        bf16x8 bq = *(const bf16x8*)(sQ + (32 * w + r) * LDQ + 16 * s + 8 * h);
#pragma unroll
        for (int m = 0; m < 4; m++) {
          bf16x8 ak = *(const bf16x8*)(skp + (size_t)(32 * m) * 128 + 16 * s);
          sc[m] = mfma32(ak, bq, sc[m]);
        }
      }
      int A[16], Bv[16];
#pragma unroll
      for (int m = 0; m < 4; m++) {
        int* dst = (m == 0) ? A : Bv;
#pragma unroll
        for (int g = 0; g < 16; g++) {
          int code = 127 ^ (32 * m + (g & 3) + 8 * (g >> 2));
          dst[g] = ((fkey(sc[m][g]) & ~127) | code) ^ (4 * h);
        }
        bitonic_sort16(dst == A ? A : Bv);
        if (m > 0) merge_top16(A, Bv);
      }
#pragma unroll
      for (int i = 0; i < 16; i++) Bv[i] = __shfl_xor(A[i], 32);
      merge_top16(A, Bv);
#pragma unroll
      for (int i = 0; i < 16; i++) L[pp][i] = A[i];
      __syncthreads();
    }
    constexpr PairTab PT = make_pairs();
    float f0[16], f1[16];
#pragma unroll
    for (int i = 0; i < 16; i++) { f0[i] = kfloat(L[0][i]); f1[i] = kfloat(L[1][i]); }
    int G0[16], G1[16];
#pragma unroll
    for (int q = 0; q < 4; q++) {
      int* dst = (q == 0) ? G0 : G1;
#pragma unroll
      for (int i = 0; i < 16; i++) {
        int cidx = q * 16 + i;
        if (PT.pi[cidx] >= 0) {
          float sv = f0[PT.pi[cidx] < 0 ? 0 : PT.pi[cidx]] + f1[PT.pj[cidx] < 0 ? 0 : PT.pj[cidx]];
          dst[i] = (fkey(sv) & ~255) | (PT.pi[cidx] << 4) | PT.pj[cidx];
        } else {
          dst[i] = (int)0x80000000;
        }
      }
      bitonic_sort16(dst == G0 ? G0 : G1);
      if (q > 0) merge_top16(G0, G1);
    }
    if (h == 0) {
#pragma unroll
      for (int i = 0; i < 16; i++) { slst[r * 33 + i] = L[0][i]; slst[r * 33 + 16 + i] = L[1][i]; }
    }
    __builtin_amdgcn_wave_barrier();
    __syncthreads();
    float vals[16], mx = -INFINITY;
    int eid[16];
#pragma unroll
    for (int k = 0; k < 16; k++) {
      int key = G0[k];
      int ci = (key >> 4) & 15, cj = key & 15;
      int k0 = slst[r * 33 + ci], k1 = slst[r * 33 + 16 + cj];
      eid[k] = (127 - (k0 & 127)) * 128 + (127 - (k1 & 127));
      vals[k] = kfloat(key);
      mx = fmaxf(mx, vals[k]);
    }
    float sum = 0.f;
#pragma unroll
    for (int k = 0; k < 16; k++) { vals[k] = __expf(vals[k] - mx); sum += vals[k]; }
    float inv = 1.f / sum;
    const int tok = t0 + 32 * w + r;
    if (h == 0) {
#pragma unroll
      for (int k = 0; k < 8; k++) { p.ids[tok * 128 + hh * 16 + k] = eid[k]; p.gates[tok * 128 + hh * 16 + k] = vals[k] * inv; }
    } else {
#pragma unroll
      for (int k = 8; k < 16; k++) { p.ids[tok * 128 + hh * 16 + k] = eid[k]; p.gates[tok * 128 + hh * 16 + k] = vals[k] * inv; }
    }
    __syncthreads();
  }
}

__device__ __forceinline__ float reduce4(float p0, float p1, float p2, float p3) {
  auto s02 = __builtin_amdgcn_permlane32_swap(__float_as_uint(p0), __float_as_uint(p2), false, false);
  auto s13 = __builtin_amdgcn_permlane32_swap(__float_as_uint(p1), __float_as_uint(p3), false, false);
  float a = __uint_as_float(s02[0]) + __uint_as_float(s02[1]);
  float b = __uint_as_float(s13[0]) + __uint_as_float(s13[1]);
  auto t = __builtin_amdgcn_permlane16_swap(__float_as_uint(a), __float_as_uint(b), false, false);
  float c = __uint_as_float(t[0]) + __uint_as_float(t[1]);
  return dpp_add16(c);
}
__device__ __forceinline__ float dot16(uint4 a, uint4 b, const unsigned (&hp)[8]) {
  float s = 0.f;
  s = __builtin_amdgcn_fdot2_f32_bf16(__builtin_bit_cast(bf2_t, a.x), __builtin_bit_cast(bf2_t, hp[0]), s, false);
  s = __builtin_amdgcn_fdot2_f32_bf16(__builtin_bit_cast(bf2_t, a.y), __builtin_bit_cast(bf2_t, hp[1]), s, false);
  s = __builtin_amdgcn_fdot2_f32_bf16(__builtin_bit_cast(bf2_t, a.z), __builtin_bit_cast(bf2_t, hp[2]), s, false);
  s = __builtin_amdgcn_fdot2_f32_bf16(__builtin_bit_cast(bf2_t, a.w), __builtin_bit_cast(bf2_t, hp[3]), s, false);
  s = __builtin_amdgcn_fdot2_f32_bf16(__builtin_bit_cast(bf2_t, b.x), __builtin_bit_cast(bf2_t, hp[4]), s, false);
  s = __builtin_amdgcn_fdot2_f32_bf16(__builtin_bit_cast(bf2_t, b.y), __builtin_bit_cast(bf2_t, hp[5]), s, false);
  s = __builtin_amdgcn_fdot2_f32_bf16(__builtin_bit_cast(bf2_t, b.z), __builtin_bit_cast(bf2_t, hp[6]), s, false);
  s = __builtin_amdgcn_fdot2_f32_bf16(__builtin_bit_cast(bf2_t, b.w), __builtin_bit_cast(bf2_t, hp[7]), s, false);
  return s;
}
__device__ __forceinline__ void axpy16(float (&acc)[16], float hk, uint4 a, uint4 b) {
  acc[0] += hk * bflo(a.x); acc[1] += hk * bfhi(a.x); acc[2] += hk * bflo(a.y); acc[3] += hk * bfhi(a.y);
  acc[4] += hk * bflo(a.z); acc[5] += hk * bfhi(a.z); acc[6] += hk * bflo(a.w); acc[7] += hk * bfhi(a.w);
  acc[8] += hk * bflo(b.x); acc[9] += hk * bfhi(b.x); acc[10] += hk * bflo(b.y); acc[11] += hk * bfhi(b.y);
  acc[12] += hk * bflo(b.z); acc[13] += hk * bfhi(b.z); acc[14] += hk * bflo(b.w); acc[15] += hk * bfhi(b.w);
}

__device__ void phase_gather(const Params& p, int bid, int nb, char* smem) {
  float* tw = (float*)smem;
  float* ts = tw + 2048;
  float* tg = ts + 2048;
  float* tf = tg + 2048;
  const int tid = threadIdx.x, lane = tid & 63, w = tid >> 6;
  for (int i = tid; i < 2048; i += 256) {
    int b = i >> 10, j = i & 1023;
    tw[i] = p.norm2_w[j] * (1.f + p.mod[b * 6144 + 4 * 1024 + j]);
    ts[i] = p.mod[b * 6144 + 3 * 1024 + j];
    tg[i] = p.mod[b * 6144 + 5 * 1024 + j];
  }
  for (int i = tid; i < 1024; i += 256) tf[i] = p.final_w[i];
  __syncthreads();
  const int e0 = lane * 8, e1 = 512 + lane * 8;
  const int GW = nb * 4;
  for (int tok = bid * 4 + w; tok < T; tok += GW) {
    asm volatile("" ::: "memory");
    const int b = tok >> 13;
    const float* xr = p.x1 + (size_t)tok * 1024;
    unsigned hp[8];
    {
      float4 v0 = *(const float4*)(xr + e0), v1 = *(const float4*)(xr + e0 + 4);
      float4 v2 = *(const float4*)(xr + e1), v3 = *(const float4*)(xr + e1 + 4);
      float ss = v0.x * v0.x + v0.y * v0.y + v0.z * v0.z + v0.w * v0.w + v1.x * v1.x + v1.y * v1.y + v1.z * v1.z + v1.w * v1.w +
                 v2.x * v2.x + v2.y * v2.y + v2.z * v2.z + v2.w * v2.w + v3.x * v3.x + v3.y * v3.y + v3.z * v3.z + v3.w * v3.w;
      ss = wave_sum(ss);
      float rstd = rsqrtf(ss * (1.f / 1024.f) + EPS);
      const float* a = tw + b * 1024;
      const float* s = ts + b * 1024;
      float4 a0 = *(const float4*)(a + e0), a1 = *(const float4*)(a + e0 + 4), a2 = *(const float4*)(a + e1), a3 = *(const float4*)(a + e1 + 4);
      float4 s0 = *(const float4*)(s + e0), s1 = *(const float4*)(s + e0 + 4), s2 = *(const float4*)(s + e1), s3 = *(const float4*)(s + e1 + 4);
      hp[0] = pack2(v0.x * rstd * a0.x + s0.x, v0.y * rstd * a0.y + s0.y);
      hp[1] = pack2(v0.z * rstd * a0.z + s0.z, v0.w * rstd * a0.w + s0.w);
      hp[2] = pack2(v1.x * rstd * a1.x + s1.x, v1.y * rstd * a1.y + s1.y);
      hp[3] = pack2(v1.z * rstd * a1.z + s1.z, v1.w * rstd * a1.w + s1.w);
      hp[4] = pack2(v2.x * rstd * a2.x + s2.x, v2.y * rstd * a2.y + s2.y);
      hp[5] = pack2(v2.z * rstd * a2.z + s2.z, v2.w * rstd * a2.w + s2.w);
      hp[6] = pack2(v3.x * rstd * a3.x + s3.x, v3.y * rstd * a3.y + s3.y);
      hp[7] = pack2(v3.z * rstd * a3.z + s3.z, v3.w * rstd * a3.w + s3.w);
    }
    const int ids0 = p.ids[tok * 128 + lane], ids1 = p.ids[tok * 128 + 64 + lane];
    const int gl = 4 * (lane & 15) + (lane >> 4);
    const float gt0 = p.gates[tok * 128 + gl], gt1 = p.gates[tok * 128 + 64 + gl];
    float acc[16];
#pragma unroll
    for (int i = 0; i < 16; i++) acc[i] = 0.f;
    uint4 bA[4], bB[4];
#pragma unroll
    for (int j = 0; j < 4; j++) {
      int id = __builtin_amdgcn_readlane(ids0, j);
      const uint4* ptr = (const uint4*)(p.ub + (size_t)id * 1024) + lane;
      bA[j] = ptr[0]; bB[j] = ptr[64];
    }
    float hid = 0.f;
#pragma unroll 1
    for (int seg = 0; seg < 4; seg++) {
      const bool isv = seg & 1;
      if (!isv) {
        float hv = 0.f;
#pragma unroll 1
        for (int g = 0; g < 16; g++) {
          float part[4];
#pragma unroll
          for (int j = 0; j < 4; j++) {
            part[j] = dot16(bA[j], bB[j], hp);
            int nx = seg * 64 + g * 4 + j + 4;
            int nseg = nx >> 6, nk = nx & 63;
            int id = __builtin_amdgcn_readlane((nseg & 2) ? ids1 : ids0, nk);
            const bf16_t* base = (nseg & 1) ? p.vb : p.ub;
            const uint4* ptr = (const uint4*)(base + (size_t)id * 1024) + lane;
            bA[j] = ptr[0]; bB[j] = ptr[64];
          }
          float r0 = reduce4(part[0], part[1], part[2], part[3]);
          hv = ((lane & 15) == g) ? r0 : hv;
        }
        float gte = (seg & 2) ? gt1 : gt0;
        hid = 0.5f * hv * (1.f + erff(hv * 0.70710678118654752f)) * gte;
      } else {
#pragma unroll 1
        for (int g = 0; g < 16; g++) {
#pragma unroll
          for (int j = 0; j < 4; j++) {
            int k = g * 4 + j;
            float hk = rdlane(hid, (k & 3) * 16 + (k >> 2));
            axpy16(acc, hk, bA[j], bB[j]);
            int nx = (seg * 64 + g * 4 + j + 4) & 255;
            int nseg = nx >> 6, nk = nx & 63;
            int id = __builtin_amdgcn_readlane((nseg & 2) ? ids1 : ids0, nk);
            const bf16_t* base = (nseg & 1) ? p.vb : p.ub;
            const uint4* ptr = (const uint4*)(base + (size_t)id * 1024) + lane;
            bA[j] = ptr[0]; bB[j] = ptr[64];
          }
        }
      }
    }
    asm volatile("" ::: "memory");
    {
      float4 v0 = *(const float4*)(xr + e0), v1 = *(const float4*)(xr + e0 + 4);
      float4 v2 = *(const float4*)(xr + e1), v3 = *(const float4*)(xr + e1 + 4);
      const float* g = tg + b * 1024;
      float4 g0 = *(const float4*)(g + e0), g1 = *(const float4*)(g + e0 + 4), g2 = *(const float4*)(g + e1), g3 = *(const float4*)(g + e1 + 4);
      float y[16];
      y[0] = v0.x + g0.x * acc[0]; y[1] = v0.y + g0.y * acc[1]; y[2] = v0.z + g0.z * acc[2]; y[3] = v0.w + g0.w * acc[3];
      y[4] = v1.x + g1.x * acc[4]; y[5] = v1.y + g1.y * acc[5]; y[6] = v1.z + g1.z * acc[6]; y[7] = v1.w + g1.w * acc[7];
      y[8] = v2.x + g2.x * acc[8]; y[9] = v2.y + g2.y * acc[9]; y[10] = v2.z + g2.z * acc[10]; y[11] = v2.w + g2.w * acc[11];
      y[12] = v3.x + g3.x * acc[12]; y[13] = v3.y + g3.y * acc[13]; y[14] = v3.z + g3.z * acc[14]; y[15] = v3.w + g3.w * acc[15];
      float ss = 0.f;
#pragma unroll
      for (int i = 0; i < 16; i++) ss += y[i] * y[i];
      ss = wave_sum(ss);
      float rstd = rsqrtf(ss * (1.f / 1024.f) + EPS);
      float4 f0 = *(const float4*)(tf + e0), f1 = *(const float4*)(tf + e0 + 4), f2 = *(const float4*)(tf + e1), f3 = *(const float4*)(tf + e1 + 4);
      float* orow = p.out + (size_t)tok * 1024;
      *(float4*)(orow + e0) = make_float4(y[0] * rstd * f0.x, y[1] * rstd * f0.y, y[2] * rstd * f0.z, y[3] * rstd * f0.w);
      *(float4*)(orow + e0 + 4) = make_float4(y[4] * rstd * f1.x, y[5] * rstd * f1.y, y[6] * rstd * f1.z, y[7] * rstd * f1.w);
      *(float4*)(orow + e1) = make_float4(y[8] * rstd * f2.x, y[9] * rstd * f2.y, y[10] * rstd * f2.z, y[11] * rstd * f2.w);
      *(float4*)(orow + e1 + 4) = make_float4(y[12] * rstd * f3.x, y[13] * rstd * f3.y, y[14] * rstd * f3.z, y[15] * rstd * f3.w);
    }
  }
}

template <int PH>
__device__ __forceinline__ void run_phase(const Params& p, int bid, int nb, char* smem) {
  if (PH == 0) phase0(p, bid, nb, smem);
  if (PH == 1) phase_norm<false>(p, bid, nb, smem);
  if (PH == 2) phase_inproj(p, bid, nb, smem);
  if (PH == 3) phase_mix_a(p, bid, nb, smem);
  if (PH == 4) phase_scan(p, bid, nb);
  if (PH == 5) phase_gla_c(p, bid, nb, smem);
  if (PH == 6) phase_outproj(p, bid, nb, smem);
  if (PH == 7) phase_norm<true>(p, bid, nb, smem);
  if (PH == 8) phase_peer_topk(p, bid, nb, smem);
  if (PH == 9) phase_gather(p, bid, nb, smem);
}

#if MULTI
template <int PH>
__global__ void __launch_bounds__(256, 2) phase_kernel(Params p) {
  __shared__ __attribute__((aligned(16))) char smem[SMEM_BYTES];
  run_phase<PH>(p, blockIdx.x, gridDim.x, smem);
}
#else
__global__ void __launch_bounds__(256, 2) fwd_megakernel(Params p) {
  __shared__ __attribute__((aligned(16))) char smem[SMEM_BYTES];
  cg::grid_group grid = cg::this_grid();
  const int bid = blockIdx.x, nb = gridDim.x;
  run_phase<0>(p, bid, nb, smem); grid.sync();
  run_phase<1>(p, bid, nb, smem); grid.sync();
  run_phase<2>(p, bid, nb, smem); grid.sync();
  run_phase<3>(p, bid, nb, smem); grid.sync();
  run_phase<4>(p, bid, nb, smem); grid.sync();
  run_phase<5>(p, bid, nb, smem); grid.sync();
  run_phase<6>(p, bid, nb, smem); grid.sync();
  run_phase<7>(p, bid, nb, smem); grid.sync();
  run_phase<8>(p, bid, nb, smem); grid.sync();
  run_phase<9>(p, bid, nb, smem);
}
#endif

extern "C" void kernel_launch(void* const* d_in, const int* in_sizes, int n_in, void* d_out, int out_size, void* d_ws,
                              size_t ws_size, hipStream_t stream) {
  Params p{};
  p.x = (const float*)d_in[0]; p.c = (const float*)d_in[1]; p.w_ada = (const float*)d_in[2]; p.b_ada = (const float*)d_in[3];
  p.norm1_w = (const float*)d_in[4]; p.w_in = (const float*)d_in[5]; p.sinks = (const float*)d_in[6];
  p.gate_up = (const float*)d_in[7]; p.gate_bias = (const float*)d_in[8]; p.gla_norm_w = (const float*)d_in[9];
  p.w_out = (const float*)d_in[10]; p.norm2_w = (const float*)d_in[11]; p.wq = (const float*)d_in[12];
  p.subkeys = (const float*)d_in[13]; p.pu = (const float*)d_in[14]; p.pv = (const float*)d_in[15];
  p.final_w = (const float*)d_in[16];
  p.out = (float*)d_out;
  char* ws = (char*)d_ws;
  size_t off = 0;
  auto take = [&](size_t bytes) { char* q = ws + off; off += (bytes + 255) & ~(size_t)255; return q; };
  p.bar = (unsigned*)take(4096);
  p.modp = (float*)take(4 * 2 * 6144 * 4);
  p.mod = (float*)take(2 * 6144 * 4);
  p.w_inT = (bf16_t*)take((size_t)NPROJ * 1024 * 2);
  p.w_outT = (bf16_t*)take((size_t)1024 * 1024 * 2);
  p.wqT = (bf16_t*)take((size_t)2048 * 1024 * 2);
  p.skb = (bf16_t*)take((size_t)262144 * 2);
  p.ub = (bf16_t*)take((size_t)16384 * 1024 * 2);
  p.vb = (bf16_t*)take((size_t)16384 * 1024 * 2);
  p.hA = (bf16_t*)take((size_t)T * 1024 * 2);
  p.proj = (bf16_t*)take((size_t)T * NPROJ * 2);
  p.x1 = (float*)p.proj;
  p.vT = (bf16_t*)take((size_t)2 * 128 * SEQ * 2);
  p.gvT = (bf16_t*)take((size_t)2 * 512 * SEQ * 2);
  p.stateT = (float*)take((size_t)1024 * 8192 * 4);
  p.ids = (int*)p.stateT;
  p.gates = (float*)((char*)p.stateT + (size_t)T * 128 * 4);
  p.gdec = (float*)take((size_t)1024 * 64 * 4);
  if (off > ws_size) { fprintf(stderr, "workspace too small: need %zu have %zu\n", off, ws_size); return; }

#if MULTI
  const int grid = 512;
  phase_kernel<0><<<grid, 256, 0, stream>>>(p);
  phase_kernel<1><<<grid, 256, 0, stream>>>(p);
  phase_kernel<2><<<grid, 256, 0, stream>>>(p);
  phase_kernel<3><<<grid, 256, 0, stream>>>(p);
  phase_kernel<4><<<grid, 256, 0, stream>>>(p);
  phase_kernel<5><<<grid, 256, 0, stream>>>(p);
  phase_kernel<6><<<grid, 256, 0, stream>>>(p);
  phase_kernel<7><<<grid, 256, 0, stream>>>(p);
  phase_kernel<8><<<grid, 256, 0, stream>>>(p);
  phase_kernel<9><<<grid, 256, 0, stream>>>(p);
#else
  static int grid_blocks = 0;
  if (!grid_blocks) {
    int dev = 0, cus = 0, per_cu = 0;
    hipGetDevice(&dev);
    hipDeviceGetAttribute(&cus, hipDeviceAttributeMultiprocessorCount, dev);
    hipOccupancyMaxActiveBlocksPerMultiprocessor(&per_cu, fwd_megakernel, 256, 0);
    if (per_cu > 2) per_cu = 2;
    grid_blocks = cus * per_cu;
  }
  void* args[] = {&p};
  hipError_t e = hipLaunchCooperativeKernel((void*)fwd_megakernel, dim3(grid_blocks), dim3(256), args, 0, stream);
  if (e != hipSuccess) fprintf(stderr, "cooperative launch failed: %s (grid %d)\n", hipGetErrorString(e), grid_blocks);
#endif
}
```

```cpp
#include <hip/hip_runtime.h>
#include <hip/hip_cooperative_groups.h>
#include <stdint.h>
#include <stdio.h>
namespace cg = cooperative_groups;

#ifndef MULTI
#define MULTI 0
#endif

typedef unsigned short bf16_t;
typedef __attribute__((ext_vector_type(8))) short bf16x8;
typedef __attribute__((ext_vector_type(4))) float f32x4;
typedef __attribute__((ext_vector_type(16))) float f32x16;
typedef __attribute__((ext_vector_type(2))) __bf16 bf2_t;
typedef __attribute__((ext_vector_type(2))) float f2_t;

constexpr int T = 16384, DM = 1024, SEQ = 8192;
constexpr int NPROJ = 2432;
constexpr int C_AK = 512, C_AV = 640, C_GQ = 768, C_GK = 1024, C_GV = 1280, C_GG = 1792, C_GLR = 2304;
constexpr float EPS = 1e-6f;
constexpr int SMEM_BYTES = 73728;
constexpr int LDK = 72;

struct Params {
  const float *x, *c, *w_ada, *b_ada, *norm1_w, *w_in, *sinks, *gate_up, *gate_bias, *gla_norm_w,
      *w_out, *norm2_w, *wq, *subkeys, *pu, *pv, *final_w;
  float* out;
  float *modp, *mod;
  bf16_t *w_inT, *w_outT, *wqT, *skb, *ub, *vb, *hA, *proj, *vT, *gvT;
  float *stateT, *gdec, *x1;
  int* ids;
  float* gates;
  unsigned* bar;
  int use_cg;
  int pad_;
};

__device__ __forceinline__ unsigned pack2(float a, float b) {
  f2_t v = {a, b};
  bf2_t r = __builtin_convertvector(v, bf2_t);
  return __builtin_bit_cast(unsigned, r);
}
__device__ __forceinline__ bf16_t f2bf(float a) { return (bf16_t)(pack2(a, 0.f) & 0xffffu); }
__device__ __forceinline__ float bf2f(bf16_t h) { return __uint_as_float(((unsigned)h) << 16); }
__device__ __forceinline__ float bflo(unsigned u) { return __uint_as_float(u << 16); }
__device__ __forceinline__ float bfhi(unsigned u) { return __uint_as_float(u & 0xffff0000u); }
__device__ __forceinline__ f32x16 mfma32(bf16x8 a, bf16x8 b, f32x16 c) {
  return __builtin_amdgcn_mfma_f32_32x32x16_bf16(a, b, c, 0, 0, 0);
}
__device__ __forceinline__ f32x16 zero16() {
  f32x16 z;
#pragma unroll
  for (int i = 0; i < 16; i++) z[i] = 0.f;
  return z;
}
__device__ __forceinline__ int rho(int g, int h) { return (g & 3) + 8 * (g >> 2) + 4 * h; }
__device__ __forceinline__ bf16x8 mk8(unsigned a, unsigned b, unsigned c, unsigned d) {
  uint4 u = make_uint4(a, b, c, d);
  return __builtin_bit_cast(bf16x8, u);
}
__device__ __forceinline__ float dpp_add16(float v) {
  v += __int_as_float(__builtin_amdgcn_update_dpp(0, __float_as_int(v), 0xB1, 0xf, 0xf, true));
  v += __int_as_float(__builtin_amdgcn_update_dpp(0, __float_as_int(v), 0x4E, 0xf, 0xf, true));
  v += __int_as_float(__builtin_amdgcn_update_dpp(0, __float_as_int(v), 0x141, 0xf, 0xf, true));
  v += __int_as_float(__builtin_amdgcn_update_dpp(0, __float_as_int(v), 0x140, 0xf, 0xf, true));
  return v;
}
__device__ __forceinline__ float rdlane(float v, int l) {
  return __int_as_float(__builtin_amdgcn_readlane(__float_as_int(v), l));
}
__device__ __forceinline__ float wave_sum(float v) {
  v = dpp_add16(v);
  float a = rdlane(v, 0), b = rdlane(v, 16), c = rdlane(v, 32), d = rdlane(v, 48);
  return (a + b) + (c + d);
}

__device__ void ph_mod(const Params& p, int item, char* smem) {
  float* sm = (float*)smem;
  int cgp = item % 96, kq = item / 96;
  int tid = threadIdx.x, c4 = tid & 15, kg = tid >> 4;
  int col = cgp * 64 + c4 * 4;
  float a0[4] = {0, 0, 0, 0}, a1[4] = {0, 0, 0, 0};
#pragma unroll 4
  for (int i = 0; i < 16; i++) {
    int k = kq * 256 + kg + 16 * i;
    float4 w = *(const float4*)(p.w_ada + (size_t)k * 6144 + col);
    float c0 = p.c[k], c1 = p.c[1024 + k];
    float s0 = c0 / (1.f + __expf(-c0)), s1 = c1 / (1.f + __expf(-c1));
    a0[0] += s0 * w.x; a0[1] += s0 * w.y; a0[2] += s0 * w.z; a0[3] += s0 * w.w;
    a1[0] += s1 * w.x; a1[1] += s1 * w.y; a1[2] += s1 * w.z; a1[3] += s1 * w.w;
  }
#pragma unroll
  for (int j = 0; j < 4; j++) {
    sm[kg * 128 + c4 * 4 + j] = a0[j];
    sm[kg * 128 + 64 + c4 * 4 + j] = a1[j];
  }
  __syncthreads();
  if (tid < 128) {
    float s = 0.f;
#pragma unroll
    for (int g = 0; g < 16; g++) s += sm[g * 128 + tid];
    int b = tid >> 6, cc = tid & 63;
    p.modp[(kq * 2 + b) * 6144 + cgp * 64 + cc] = s;
  }
  __syncthreads();
}

__device__ void ph_transpose(const float* __restrict__ W, int N, bf16_t* __restrict__ out, int kt, int nt, char* smem) {
  float* sm = (float*)smem;
  int tid = threadIdx.x;
  int cn = tid & 63, rk = tid >> 6;
  int n = nt * 64 + cn;
#pragma unroll 4
  for (int i = 0; i < 16; i++) {
    int k = rk + 4 * i;
    float v = (n < N) ? W[(size_t)(kt * 64 + k) * N + n] : 0.f;
    sm[k * 65 + cn] = v;
  }
  __syncthreads();
  int nn = tid >> 2, kc = (tid & 3) * 16;
  unsigned pk[8];
#pragma unroll
  for (int j = 0; j < 8; j++) pk[j] = pack2(sm[(kc + 2 * j) * 65 + nn], sm[(kc + 2 * j + 1) * 65 + nn]);
  uint4* dst = (uint4*)(out + (size_t)(nt * 64 + nn) * 1024 + kt * 64 + kc);
  dst[0] = make_uint4(pk[0], pk[1], pk[2], pk[3]);
  dst[1] = make_uint4(pk[4], pk[5], pk[6], pk[7]);
  __syncthreads();
}

__device__ __forceinline__ void ph_convert(const float* __restrict__ src, bf16_t* __restrict__ dst, int item) {
  size_t off = (size_t)item * 2048 + threadIdx.x * 8;
  float4 a = *(const float4*)(src + off), b = *(const float4*)(src + off + 4);
  *(uint4*)(dst + off) = make_uint4(pack2(a.x, a.y), pack2(a.z, a.w), pack2(b.x, b.y), pack2(b.z, b.w));
}

__device__ void phase0(const Params& p, int bid, int nb, char* smem) {
  constexpr int N_MOD = 384, N_TIN = 16 * 38, N_TOUT = 16 * 16, N_TQ = 16 * 32;
  constexpr int N_SK = 128, N_U = 8192;
  constexpr int TOTAL = N_MOD + N_TIN + N_TOUT + N_TQ + N_SK + 2 * N_U;
  for (int it = bid; it < TOTAL; it += nb) {
    int i = it;
    if (i < N_MOD) { ph_mod(p, i, smem); continue; }
    i -= N_MOD;
    if (i < N_TIN) { ph_transpose(p.w_in, 2320, p.w_inT, i & 15, i >> 4, smem); continue; }
    i -= N_TIN;
    if (i < N_TOUT) { ph_transpose(p.w_out, 1024, p.w_outT, i & 15, i >> 4, smem); continue; }
    i -= N_TOUT;
    if (i < N_TQ) { ph_transpose(p.wq, 2048, p.wqT, i & 15, i >> 4, smem); continue; }
    i -= N_TQ;
    if (i < N_SK) { ph_convert(p.subkeys, p.skb, i); continue; }
    i -= N_SK;
    if (i < N_U) { ph_convert(p.pu, p.ub, i); continue; }
    i -= N_U;
    ph_convert(p.pv, p.vb, i);
  }
}

template <bool SECOND>
__device__ void phase_norm(const Params& p, int bid, int nb, char* smem) {
  float* tw = (float*)smem;
  float* ts = tw + 1024;
  const int tid = threadIdx.x, lane = tid & 63, w = tid >> 6;
  const float* src = SECOND ? p.x1 : p.x;
  const float* nw = SECOND ? p.norm2_w : p.norm1_w;
  for (int item = bid; item < 256; item += nb) {
    int b = item >> 7;
    if (!SECOND) {
      if (item < 48) {
        int j = item * 256 + tid;
        int bb = j / 6144, jj = j % 6144;
        float s = p.b_ada[jj];
#pragma unroll
        for (int q = 0; q < 4; q++) s += p.modp[(q * 2 + bb) * 6144 + jj];
        p.mod[j] = s;
      }
      for (int j = tid; j < 1024; j += 256) {
        float sc = p.b_ada[1024 + j], sh = p.b_ada[j];
#pragma unroll
        for (int q = 0; q < 4; q++) {
          sc += p.modp[(q * 2 + b) * 6144 + 1024 + j];
          sh += p.modp[(q * 2 + b) * 6144 + j];
        }
        tw[j] = nw[j] * (1.f + sc);
        ts[j] = sh;
      }
    } else {
      for (int j = tid; j < 1024; j += 256) {
        tw[j] = nw[j] * (1.f + p.mod[b * 6144 + 4 * 1024 + j]);
        ts[j] = p.mod[b * 6144 + 3 * 1024 + j];
      }
    }
    __syncthreads();
    for (int tt = 0; tt < 16; tt++) {
      int tok = item * 64 + w * 16 + tt;
      const float* xr = src + (size_t)tok * 1024;
      float4 v[4];
      float ss = 0.f;
#pragma unroll
      for (int i = 0; i < 4; i++) {
        v[i] = *(const float4*)(xr + lane * 4 + 256 * i);
        ss += v[i].x * v[i].x + v[i].y * v[i].y + v[i].z * v[i].z + v[i].w * v[i].w;
      }
      ss = wave_sum(ss);
      float rstd = rsqrtf(ss * (1.f / 1024.f) + EPS);
#pragma unroll
      for (int i = 0; i < 4; i++) {
        int e = lane * 4 + 256 * i;
        float4 a = *(const float4*)(tw + e), s = *(const float4*)(ts + e);
        float o0 = v[i].x * rstd * a.x + s.x, o1 = v[i].y * rstd * a.y + s.y;
        float o2 = v[i].z * rstd * a.z + s.z, o3 = v[i].w * rstd * a.w + s.w;
        *(uint2*)(p.hA + (size_t)tok * 1024 + e) = make_uint2(pack2(o0, o1), pack2(o2, o3));
      }
    }
    __syncthreads();
  }
}

__device__ __forceinline__ void gemm_mainloop(const bf16_t* __restrict__ Wt, const bf16_t* __restrict__ Xa,
                                              int n0, int t0, char* smem, f32x16 (&acc)[2][2]) {
  const int tid = threadIdx.x, lane = tid & 63, w = tid >> 6, wn = w >> 1, wt = w & 1;
  const int r = lane & 31, h = lane >> 5;
  bf16_t* sW = (bf16_t*)smem;
  bf16_t* sX = sW + 2 * 128 * LDK;
  uint4 rw[4], rx[4];
  const bf16_t* gW = Wt + (size_t)(n0 + (tid >> 3)) * 1024 + (tid & 7) * 8;
  const bf16_t* gX = Xa + (size_t)(t0 + (tid >> 3)) * 1024 + (tid & 7) * 8;
  const int soff = (tid >> 3) * LDK + (tid & 7) * 8;
#pragma unroll
  for (int i = 0; i < 2; i++)
#pragma unroll
    for (int j = 0; j < 2; j++) acc[i][j] = zero16();
#pragma unroll
  for (int i = 0; i < 4; i++) {
    rw[i] = *(const uint4*)(gW + (size_t)i * 32 * 1024);
    rx[i] = *(const uint4*)(gX + (size_t)i * 32 * 1024);
  }
#pragma unroll
  for (int i = 0; i < 4; i++) {
    *(uint4*)(sW + soff + i * 32 * LDK) = rw[i];
    *(uint4*)(sX + soff + i * 32 * LDK) = rx[i];
  }
  __syncthreads();
  for (int kt = 0; kt < 16; kt++) {
    if (kt + 1 < 16) {
#pragma unroll
      for (int i = 0; i < 4; i++) {
        rw[i] = *(const uint4*)(gW + (size_t)i * 32 * 1024 + (kt + 1) * 64);
        rx[i] = *(const uint4*)(gX + (size_t)i * 32 * 1024 + (kt + 1) * 64);
      }
    }
    const bf16_t* bW = sW + (kt & 1) * 128 * LDK + (64 * wn + r) * LDK + h * 8;
    const bf16_t* bX = sX + (kt & 1) * 128 * LDK + (64 * wt + r) * LDK + h * 8;
#pragma unroll
    for (int s = 0; s < 4; s++) {
      bf16x8 aw[2], bx[2];
#pragma unroll
      for (int i = 0; i < 2; i++) aw[i] = *(const bf16x8*)(bW + i * 32 * LDK + s * 16);
#pragma unroll
      for (int j = 0; j < 2; j++) bx[j] = *(const bf16x8*)(bX + j * 32 * LDK + s * 16);
#pragma unroll
      for (int i = 0; i < 2; i++)
#pragma unroll
        for (int j = 0; j < 2; j++) acc[i][j] = mfma32(aw[i], bx[j], acc[i][j]);
    }
    if (kt + 1 < 16) {
      const int bo = ((kt + 1) & 1) * 128 * LDK;
#pragma unroll
      for (int i = 0; i < 4; i++) {
        *(uint4*)(sW + bo + soff + i * 32 * LDK) = rw[i];
        *(uint4*)(sX + bo + soff + i * 32 * LDK) = rx[i];
      }
    }
    __syncthreads();
  }
}

__device__ void phase_inproj(const Params& p, int bid, int nb, char* smem) {
  const int tid = threadIdx.x, lane = tid & 63, w = tid >> 6, wn = w >> 1, wt = w & 1;
  const int r = lane & 31, h = lane >> 5;
  for (int item = bid; item < 19 * 128; item += nb) {
    int ntile = item % 19, ttile = item / 19;
    int n0 = ntile * 128, t0 = ttile * 128;
    f32x16 acc[2][2];
    gemm_mainloop(p.w_inT, p.hA, n0, t0, smem, acc);
    const bool isAV = (ntile == 5), isGV = (ntile >= 10 && ntile < 14);
#pragma unroll
    for (int i = 0; i < 2; i++)
#pragma unroll
      for (int j = 0; j < 2; j++) {
        int tok = t0 + 64 * wt + 32 * j + r;
        if (isAV || isGV) {
          int b = tok >> 13, s = tok & 8191;
#pragma unroll
          for (int g = 0; g < 16; g++) {
            int n = n0 + 64 * wn + 32 * i + rho(g, h);
            bf16_t v = f2bf(acc[i][j][g]);
            if (isAV) p.vT[((size_t)(b * 128 + (n - C_AV))) * SEQ + s] = v;
            else p.gvT[((size_t)(b * 512 + (n - C_GV))) * SEQ + s] = v;
          }
        } else {
#pragma unroll
          for (int gg = 0; gg < 4; gg++) {
            int n = n0 + 64 * wn + 32 * i + 8 * gg + 4 * h;
            *(uint2*)(p.proj + (size_t)tok * NPROJ + n) =
                make_uint2(pack2(acc[i][j][4 * gg], acc[i][j][4 * gg + 1]), pack2(acc[i][j][4 * gg + 2], acc[i][j][4 * gg + 3]));
          }
        }
      }
  }
}

__device__ void ph_attn(const Params& p, int item) {
  const int tid = threadIdx.x, lane = tid & 63, w = tid >> 6, r = lane & 31, h = lane >> 5;
  const int hq = item & 7, nblk = (item >> 3) & 63, b = item >> 9, kvh = hq >> 2;
  const int q_tok = b * SEQ + nblk * 128 + 32 * w + r;
  bf16x8 qf[4];
#pragma unroll
  for (int s = 0; s < 4; s++) qf[s] = *(const bf16x8*)(p.proj + (size_t)q_tok * NPROJ + hq * 64 + s * 16 + h * 8);
  f32x16 sa[5];
#pragma unroll
  for (int tt = 0; tt < 5; tt++) {
    int kpos = (nblk - 1) * 128 + 32 * (w + tt) + r;
    kpos = kpos < 0 ? 0 : kpos;
    const bf16_t* kptr = p.proj + (size_t)(b * SEQ + kpos) * NPROJ + C_AK + kvh * 64 + h * 8;
    sa[tt] = zero16();
#pragma unroll
    for (int s = 0; s < 4; s++) {
      bf16x8 kf = *(const bf16x8*)(kptr + s * 16);
      sa[tt] = mfma32(kf, qf[s], sa[tt]);
    }
  }
  const float L2E = 1.4426950408889634f;
  const float sc = 0.125f * L2E;
  const float sinkt = p.sinks[hq] * L2E;
  float m = sinkt;
#pragma unroll
  for (int tt = 0; tt < 5; tt++)
#pragma unroll
    for (int g = 0; g < 16; g++) {
      int rr = rho(g, h);
      int d = 32 * tt + rr - r;
      bool valid = (d >= 1) && (d <= 128) && (nblk > 0 || (32 * (w + tt) + rr) >= 128);
      float v = valid ? sa[tt][g] * sc : -INFINITY;
      sa[tt][g] = v;
      m = fmaxf(m, v);
    }
  m = fmaxf(m, __shfl_xor(m, 32));
  float sum = 0.f;
#pragma unroll
  for (int tt = 0; tt < 5; tt++)
#pragma unroll
    for (int g = 0; g < 16; g++) {
      float e = exp2f(sa[tt][g] - m);
      sa[tt][g] = e;
      sum += e;
    }
  sum += __shfl_xor(sum, 32);
  sum += exp2f(sinkt - m);
  const float inv = 1.f / sum;
  f32x16 o[2];
  o[0] = zero16(); o[1] = zero16();
#pragma unroll
  for (int tt = 0; tt < 5; tt++)
#pragma unroll
    for (int s2 = 0; s2 < 2; s2++) {
      bf16x8 pf = mk8(pack2(sa[tt][8 * s2 + 0], sa[tt][8 * s2 + 1]), pack2(sa[tt][8 * s2 + 2], sa[tt][8 * s2 + 3]),
                      pack2(sa[tt][8 * s2 + 4], sa[tt][8 * s2 + 5]), pack2(sa[tt][8 * s2 + 6], sa[tt][8 * s2 + 7]));
      int kb = (nblk - 1) * 128 + 32 * (w + tt) + 16 * s2 + 4 * h;
      kb = kb < 0 ? 0 : kb;
#pragma unroll
      for (int mt = 0; mt < 2; mt++) {
        const bf16_t* vp = p.vT + ((size_t)(b * 128 + kvh * 64 + 32 * mt + r)) * SEQ + kb;
        uint2 lo = *(const uint2*)vp, hi = *(const uint2*)(vp + 8);
        o[mt] = mfma32(mk8(lo.x, lo.y, hi.x, hi.y), pf, o[mt]);
      }
    }
#pragma unroll
  for (int mt = 0; mt < 2; mt++)
#pragma unroll
    for (int gg = 0; gg < 4; gg++) {
      int d0 = 32 * mt + 8 * gg + 4 * h;
      *(uint2*)(p.hA + (size_t)q_tok * 1024 + hq * 64 + d0) =
          make_uint2(pack2(o[mt][4 * gg] * inv, o[mt][4 * gg + 1] * inv), pack2(o[mt][4 * gg + 2] * inv, o[mt][4 * gg + 3] * inv));
    }
}

__device__ __forceinline__ void gla_decay(const Params& p, int b, int hh, int c, char* smem, float (&bl)[16], float& blast) {
  float* sglr = (float*)smem;
  float* sgrp = sglr + 1024;
  const int tid = threadIdx.x, d = tid & 63, tq = tid >> 6;
  const int tok0 = b * SEQ + c * 64;
  {
    int idx = tid * 4, t = idx >> 4, rr = idx & 15;
    uint2 u = *(const uint2*)(p.proj + (size_t)(tok0 + t) * NPROJ + C_GLR + rr);
    sglr[idx] = bflo(u.x); sglr[idx + 1] = bfhi(u.x); sglr[idx + 2] = bflo(u.y); sglr[idx + 3] = bfhi(u.y);
  }
  float gu[16];
#pragma unroll
  for (int rr = 0; rr < 16; rr++) gu[rr] = p.gate_up[rr * 256 + hh * 64 + d];
  const float bias = p.gate_bias[hh * 64 + d];
  __syncthreads();
  float run = 0.f;
#pragma unroll
  for (int i = 0; i < 16; i++) {
    int t = tq * 16 + i;
    float z = bias;
#pragma unroll
    for (int q = 0; q < 4; q++) {
      float4 g4 = *(const float4*)(sglr + t * 16 + q * 4);
      z += g4.x * gu[q * 4] + g4.y * gu[q * 4 + 1] + g4.z * gu[q * 4 + 2] + g4.w * gu[q * 4 + 3];
    }
    float la = (fminf(z, 0.f) - __logf(1.f + __expf(-fabsf(z)))) * (1.f / 16.f);
    run += la;
    bl[i] = run;
  }
  sgrp[tq * 64 + d] = run;
  __syncthreads();
  float off = 0.f, tot = 0.f;
#pragma unroll
  for (int q = 0; q < 4; q++) {
    float v = sgrp[q * 64 + d];
    tot += v;
    off += (q < tq) ? v : 0.f;
  }
#pragma unroll
  for (int i = 0; i < 16; i++) bl[i] += off;
  blast = tot;
}

__device__ void ph_gla_a(const Params& p, int item, char* smem) {
  const int tid = threadIdx.x, lane = tid & 63, w = tid >> 6, r = lane & 31, h = lane >> 5;
  const int d = tid & 63, tq = tid >> 6;
  const int c = item & 127, hh = (item >> 7) & 3, b = item >> 9;
  const int tok0 = b * SEQ + c * 64;
  float bl[16], blast;
  gla_decay(p, b, hh, c, smem, bl, blast);
  bf16_t* k2T = (bf16_t*)(smem + 8192);
  unsigned pk[8];
#pragma unroll
  for (int i = 0; i < 8; i++) {
    int t0 = tq * 16 + 2 * i;
    float k0 = bf2f(p.proj[(size_t)(tok0 + t0) * NPROJ + C_GK + hh * 64 + d]);
    float k1 = bf2f(p.proj[(size_t)(tok0 + t0 + 1) * NPROJ + C_GK + hh * 64 + d]);
    pk[i] = pack2(k0 * __expf(blast - bl[2 * i]), k1 * __expf(blast - bl[2 * i + 1]));
  }
  *(uint4*)(k2T + d * LDK + tq * 16) = make_uint4(pk[0], pk[1], pk[2], pk[3]);
  *(uint4*)(k2T + d * LDK + tq * 16 + 8) = make_uint4(pk[4], pk[5], pk[6], pk[7]);
  if (tq == 0) p.gdec[item * 64 + d] = __expf(blast);
  __syncthreads();
  f32x16 acc[2];
  acc[0] = zero16(); acc[1] = zero16();
  const bf16_t* vrow = p.gvT + ((size_t)(b * 512 + hh * 128 + 32 * w + r)) * SEQ + c * 64 + 8 * h;
#pragma unroll
  for (int s = 0; s < 4; s++) {
    bf16x8 av = *(const bf16x8*)(vrow + 16 * s);
#pragma unroll
    for (int nt = 0; nt < 2; nt++) {
      bf16x8 bk = *(const bf16x8*)(k2T + (32 * nt + r) * LDK + 16 * s + 8 * h);
      acc[nt] = mfma32(av, bk, acc[nt]);
    }
  }
  float* st = p.stateT + (size_t)item * 8192;
#pragma unroll
  for (int nt = 0; nt < 2; nt++)
#pragma unroll
    for (int g = 0; g < 16; g++) st[(32 * w + rho(g, h)) * 64 + 32 * nt + r] = acc[nt][g];
  __syncthreads();
}

__device__ void phase_mix_a(const Params& p, int bid, int nb, char* smem) {
  for (int it = bid; it < 2048; it += nb) {
    if (it < 1024) ph_gla_a(p, it, smem);
    else ph_attn(p, it - 1024);
  }
}

__device__ void phase_scan(const Params& p, int bid, int nb) {
  for (int it = bid; it < 256; it += nb) {
    int bh = it >> 5, e = (it & 31) * 256 + threadIdx.x, dk = e & 63;
    float st = 0.f;
    for (int c0 = 0; c0 < 128; c0 += 16) {
      float sl[16], gd[16];
#pragma unroll
      for (int j = 0; j < 16; j++) {
        sl[j] = p.stateT[(size_t)(bh * 128 + c0 + j) * 8192 + e];
        gd[j] = p.gdec[(bh * 128 + c0 + j) * 64 + dk];
      }
#pragma unroll
      for (int j = 0; j < 16; j++) {
        p.stateT[(size_t)(bh * 128 + c0 + j) * 8192 + e] = st;
        st = gd[j] * st + sl[j];
      }
    }
  }
}

__device__ void phase_gla_c(const Params& p, int bid, int nb, char* smem) {
  const int tid = threadIdx.x, lane = tid & 63, w = tid >> 6, r = lane & 31, h = lane >> 5;
  const int d = tid & 63, tq = tid >> 6;
  bf16_t* qs = (bf16_t*)(smem + 8192);
  bf16_t* ks = qs + 64 * LDK;
  float* sred = (float*)(smem + 8192 + 2 * 64 * LDK * 2);
  for (int item = bid; item < 1024; item += nb) {
    const int c = item & 127, hh = (item >> 7) & 3, b = item >> 9;
    const int tok0 = b * SEQ + c * 64;
    float bl[16], blast;
    gla_decay(p, b, hh, c, smem, bl, blast);
#pragma unroll
    for (int i = 0; i < 16; i++) {
      int t = tq * 16 + i;
      const bf16_t* pr = p.proj + (size_t)(tok0 + t) * NPROJ + hh * 64 + d;
      float qv = bf2f(pr[C_GQ]), kv = bf2f(pr[C_GK]);
      qs[t * LDK + d] = f2bf(qv * 0.125f * __expf(bl[i]));
      ks[t * LDK + d] = f2bf(kv * __expf(-bl[i]));
    }
    __syncthreads();
    const int tt = w & 1, dvh = w >> 1;
    f32x16 at[2];
    at[0] = zero16(); at[1] = zero16();
#pragma unroll
    for (int s = 0; s < 4; s++) {
      bf16x8 bq = *(const bf16x8*)(qs + (32 * tt + r) * LDK + 16 * s + 8 * h);
      bf16x8 a0 = *(const bf16x8*)(ks + r * LDK + 16 * s + 8 * h);
      at[0] = mfma32(a0, bq, at[0]);
      if (tt == 1) {
        bf16x8 a1 = *(const bf16x8*)(ks + (32 + r) * LDK + 16 * s + 8 * h);
        at[1] = mfma32(a1, bq, at[1]);
      }
    }
#pragma unroll
    for (int g = 0; g < 16; g++) {
      int rr = rho(g, h);
      if (tt == 0) { if (rr > r) at[0][g] = 0.f; }
      else { if (rr > r) at[1][g] = 0.f; }
    }
    f32x16 o[2];
    o[0] = zero16(); o[1] = zero16();
#pragma unroll
    for (int st = 0; st < 2; st++) {
      if (st <= tt) {
#pragma unroll
        for (int s2 = 0; s2 < 2; s2++) {
          bf16x8 pf = mk8(pack2(at[st][8 * s2 + 0], at[st][8 * s2 + 1]), pack2(at[st][8 * s2 + 2], at[st][8 * s2 + 3]),
                          pack2(at[st][8 * s2 + 4], at[st][8 * s2 + 5]), pack2(at[st][8 * s2 + 6], at[st][8 * s2 + 7]));
#pragma unroll
          for (int m2 = 0; m2 < 2; m2++) {
            int mt = 2 * dvh + m2;
            const bf16_t* vp = p.gvT + ((size_t)(b * 512 + hh * 128 + 32 * mt + r)) * SEQ + c * 64 + 32 * st + 16 * s2 + 4 * h;
            uint2 lo = *(const uint2*)vp, hi = *(const uint2*)(vp + 8);
            o[m2] = mfma32(mk8(lo.x, lo.y, hi.x, hi.y), pf, o[m2]);
          }
        }
      }
    }
    const float* stp = p.stateT + (size_t)item * 8192;
#pragma unroll
    for (int s = 0; s < 4; s++) {
      bf16x8 bq = *(const bf16x8*)(qs + (32 * tt + r) * LDK + 16 * s + 8 * h);
#pragma unroll
      for (int m2 = 0; m2 < 2; m2++) {
        int mt = 2 * dvh + m2;
        const float* sp = stp + (32 * mt + r) * 64 + 16 * s + 8 * h;
        float4 f0 = *(const float4*)sp, f1 = *(const float4*)(sp + 4);
        o[m2] = mfma32(mk8(pack2(f0.x, f0.y), pack2(f0.z, f0.w), pack2(f1.x, f1.y), pack2(f1.z, f1.w)), bq, o[m2]);
      }
    }
    float ss = 0.f;
#pragma unroll
    for (int m2 = 0; m2 < 2; m2++)
#pragma unroll
      for (int g = 0; g < 16; g++) ss += o[m2][g] * o[m2][g];
    ss += __shfl_xor(ss, 32);
    if (h == 0) sred[dvh * 64 + 32 * tt + r] = ss;
    __syncthreads();
    float tot = sred[32 * tt + r] + sred[64 + 32 * tt + r];
    float rstd = rsqrtf(tot * (1.f / 128.f) + EPS);
    const int tok = tok0 + 32 * tt + r;
#pragma unroll
    for (int m2 = 0; m2 < 2; m2++)
#pragma unroll
      for (int gg = 0; gg < 4; gg++) {
        int dv0 = 32 * (2 * dvh + m2) + 8 * gg + 4 * h;
        uint2 gu = *(const uint2*)(p.proj + (size_t)tok * NPROJ + C_GG + hh * 128 + dv0);
        float4 nw = *(const float4*)(p.gla_norm_w + dv0);
        float g0 = bflo(gu.x), g1 = bfhi(gu.x), g2 = bflo(gu.y), g3 = bfhi(gu.y);
        float r0 = o[m2][4 * gg] * rstd * nw.x * (g0 / (1.f + __expf(-g0)));
        float r1 = o[m2][4 * gg + 1] * rstd * nw.y * (g1 / (1.f + __expf(-g1)));
        float r2 = o[m2][4 * gg + 2] * rstd * nw.z * (g2 / (1.f + __expf(-g2)));
        float r3 = o[m2][4 * gg + 3] * rstd * nw.w * (g3 / (1.f + __expf(-g3)));
        *(uint2*)(p.hA + (size_t)tok * 1024 + 512 + hh * 128 + dv0) = make_uint2(pack2(r0, r1), pack2(r2, r3));
      }
    __syncthreads();
  }
}

__device__ void phase_outproj(const Params& p, int bid, int nb, char* smem) {
  const int tid = threadIdx.x, lane = tid & 63, w = tid >> 6, wn = w >> 1, wt = w & 1;
  const int r = lane & 31, h = lane >> 5;
  for (int item = bid; item < 8 * 128; item += nb) {
    int ntile = item & 7, ttile = item >> 3;
    int n0 = ntile * 128, t0 = ttile * 128;
    int b = t0 >> 13;
    f32x16 acc[2][2];
    gemm_mainloop(p.w_outT, p.hA, n0, t0, smem, acc);
    const float* g1 = p.mod + b * 6144 + 2 * 1024;
#pragma unroll
    for (int i = 0; i < 2; i++)
#pragma unroll
      for (int j = 0; j < 2; j++) {
        int tok = t0 + 64 * wt + 32 * j + r;
#pragma unroll
        for (int gg = 0; gg < 4; gg++) {
          int n = n0 + 64 * wn + 32 * i + 8 * gg + 4 * h;
          float4 xv = *(const float4*)(p.x + (size_t)tok * 1024 + n);
          float4 gv = *(const float4*)(g1 + n);
          float4 ov;
          ov.x = xv.x + gv.x * acc[i][j][4 * gg];
          ov.y = xv.y + gv.y * acc[i][j][4 * gg + 1];
          ov.z = xv.z + gv.z * acc[i][j][4 * gg + 2];
          ov.w = xv.w + gv.w * acc[i][j][4 * gg + 3];
          *(float4*)(p.x1 + (size_t)tok * 1024 + n) = ov;
        }
      }
  }
}

__device__ __forceinline__ int fkey(float f) {
  int b = __float_as_int(f);
  return b ^ ((b >> 31) & 0x7fffffff);
}
__device__ __forceinline__ float kfloat(int k) { return __int_as_float(k ^ ((k >> 31) & 0x7fffffff)); }

__device__ __forceinline__ void bitonic_sort16(int (&a)[16]) {
#pragma unroll
  for (int k = 2; k <= 16; k <<= 1) {
#pragma unroll
    for (int j = k >> 1; j > 0; j >>= 1) {
#pragma unroll
      for (int i = 0; i < 16; i++) {
        int l = i ^ j;
        if (l > i) {
          bool up = ((i & k) == 0) || (k == 16);
          int mx = max(a[i], a[l]), mn = min(a[i], a[l]);
          a[i] = up ? mx : mn;
          a[l] = up ? mn : mx;
        }
      }
    }
  }
}
__device__ __forceinline__ void bitonic_merge16(int (&a)[16]) {
#pragma unroll
  for (int j = 8; j > 0; j >>= 1) {
#pragma unroll
    for (int i = 0; i < 16; i++) {
      int l = i ^ j;
      if (l > i) {
        int mx = max(a[i], a[l]), mn = min(a[i], a[l]);
        a[i] = mx; a[l] = mn;
      }
    }
  }
}
__device__ __forceinline__ void merge_top16(int (&a)[16], const int (&b)[16]) {
#pragma unroll
  for (int i = 0; i < 16; i++) a[i] = max(a[i], b[15 - i]);
  bitonic_merge16(a);
}

struct PairTab { int pi[64], pj[64]; };
__host__ __device__ constexpr PairTab make_pairs() {
  PairTab t{};
  int n = 0;
  for (int i = 0; i < 16; i++)
    for (int j = 0; j < 16; j++)
      if ((i + 1) * (j + 1) <= 16) { t.pi[n] = i; t.pj[n] = j; n++; }
  for (; n < 64; n++) { t.pi[n] = -1; t.pj[n] = -1; }
  return t;
}

__device__ void phase_peer_topk(const Params& p, int bid, int nb, char* smem) {
  const int tid = threadIdx.x, lane = tid & 63, w = tid >> 6, wn = w >> 1, wt = w & 1;
  const int r = lane & 31, h = lane >> 5;
  constexpr int LDQ = 136;
  bf16_t* sQ = (bf16_t*)smem;
  int* slst = (int*)(smem + 40960) + w * (32 * 33);
  for (int item = bid; item < 1024; item += nb) {
    const int hh = item & 7, t0 = (item >> 3) * 128;
    int L[2][16];
#pragma unroll
    for (int pp = 0; pp < 2; pp++) {
      f32x16 acc[2][2];
      gemm_mainloop(p.wqT, p.hA, hh * 256 + pp * 128, t0, smem, acc);
#pragma unroll
      for (int i = 0; i < 2; i++)
#pragma unroll
        for (int j = 0; j < 2; j++)
#pragma unroll
          for (int gg = 0; gg < 4; gg++) {
            int tl = 64 * wt + 32 * j + r, qc = 64 * wn + 32 * i + 8 * gg + 4 * h;
            *(uint2*)(sQ + tl * LDQ + qc) =
                make_uint2(pack2(acc[i][j][4 * gg], acc[i][j][4 * gg + 1]), pack2(acc[i][j][4 * gg + 2], acc[i][j][4 * gg + 3]));
          }
      __syncthreads();
      f32x16 sc[4];
#pragma unroll
      for (int m = 0; m < 4; m++) sc[m] = zero16();
      const bf16_t* skp = p.skb + (size_t)((hh * 2 + pp) * 128 + r) * 128 + 8 * h;
#pragma unroll
      for (int s = 0; s < 8; s++) {
        bf16x8 bq = *(const bf16x8*)(sQ + (32 * w + r) * LDQ + 16 * s + 8 * h);
#pragma unroll
        for (int m = 0; m < 4; m++) {
          bf16x8 ak = *(const bf16x8*)(skp + (size_t)(32 * m) * 128 + 16 * s);
          sc[m] = mfma32(ak, bq, sc[m]);
        }
      }
      int A[16], Bv[16];
#pragma unroll
      for (int m = 0; m < 4; m++) {
        int* dst = (m == 0) ? A : Bv;
#pragma unroll
        for (int g = 0; g < 16; g++) {
          int code = 127 ^ (32 * m + (g & 3) + 8 * (g >> 2));
          dst[g] = ((fkey(sc[m][g]) & ~127) | code) ^ (4 * h);
        }
        bitonic_sort16(dst == A ? A : Bv);
        if (m > 0) merge_top16(A, Bv);
      }
#pragma unroll
      for (int i = 0; i < 16; i++) Bv[i] = __shfl_xor(A[i], 32);
      merge_top16(A, Bv);
#pragma unroll
      for (int i = 0; i < 16; i++) L[pp][i] = A[i];
      __syncthreads();
    }
    constexpr PairTab PT = make_pairs();
    float f0[16], f1[16];
#pragma unroll
    for (int i = 0; i < 16; i++) { f0[i] = kfloat(L[0][i]); f1[i] = kfloat(L[1][i]); }
    int G0[16], G1[16];
#pragma unroll
    for (int q = 0; q < 4; q++) {
      int* dst = (q == 0) ? G0 : G1;
#pragma unroll
      for (int i = 0; i < 16; i++) {
        int cidx = q * 16 + i;
        if (PT.pi[cidx] >= 0) {
          float sv = f0[PT.pi[cidx] < 0 ? 0 : PT.pi[cidx]] + f1[PT.pj[cidx] < 0 ? 0 : PT.pj[cidx]];
          dst[i] = (fkey(sv) & ~255) | (PT.pi[cidx] << 4) | PT.pj[cidx];
        } else {
          dst[i] = (int)0x80000000;
        }
      }
      bitonic_sort16(dst == G0 ? G0 : G1);
      if (q > 0) merge_top16(G0, G1);
    }
    if (h == 0) {
#pragma unroll
      for (int i = 0; i < 16; i++) { slst[r * 33 + i] = L[0][i]; slst[r * 33 + 16 + i] = L[1][i]; }
    }
    __builtin_amdgcn_wave_barrier();
    __syncthreads();
    float vals[16], mx = -INFINITY;
    int eid[16];
#pragma unroll
    for (int k = 0; k < 16; k++) {
      int key = G0[k];
      int ci = (key >> 4) & 15, cj = key & 15;
      int k0 = slst[r * 33 + ci], k1 = slst[r * 33 + 16 + cj];
      eid[k] = (127 - (k0 & 127)) * 128 + (127 - (k1 & 127));
      vals[k] = kfloat(key);
      mx = fmaxf(mx, vals[k]);
    }
    float sum = 0.f;
#pragma unroll
    for (int k = 0; k < 16; k++) { vals[k] = __expf(vals[k] - mx); sum += vals[k]; }
    float inv = 1.f / sum;
    const int tok = t0 + 32 * w + r;
    if (h == 0) {
#pragma unroll
      for (int k = 0; k < 8; k++) { p.ids[tok * 128 + hh * 16 + k] = eid[k]; p.gates[tok * 128 + hh * 16 + k] = vals[k] * inv; }
    } else {
#pragma unroll
      for (int k = 8; k < 16; k++) { p.ids[tok * 128 + hh * 16 + k] = eid[k]; p.gates[tok * 128 + hh * 16 + k] = vals[k] * inv; }
    }
    __syncthreads();
  }
}

__device__ __forceinline__ float reduce4(float p0, float p1, float p2, float p3) {
  auto s02 = __builtin_amdgcn_permlane32_swap(__float_as_uint(p0), __float_as_uint(p2), false, false);
  auto s13 = __builtin_amdgcn_permlane32_swap(__float_as_uint(p1), __float_as_uint(p3), false, false);
  float a = __uint_as_float(s02[0]) + __uint_as_float(s02[1]);
  float b = __uint_as_float(s13[0]) + __uint_as_float(s13[1]);
  auto t = __builtin_amdgcn_permlane16_swap(__float_as_uint(a), __float_as_uint(b), false, false);
  float c = __uint_as_float(t[0]) + __uint_as_float(t[1]);
  return dpp_add16(c);
}
__device__ __forceinline__ float dot16(uint4 a, uint4 b, const unsigned (&hp)[8]) {
  float s = 0.f;
  s = __builtin_amdgcn_fdot2_f32_bf16(__builtin_bit_cast(bf2_t, a.x), __builtin_bit_cast(bf2_t, hp[0]), s, false);
  s = __builtin_amdgcn_fdot2_f32_bf16(__builtin_bit_cast(bf2_t, a.y), __builtin_bit_cast(bf2_t, hp[1]), s, false);
  s = __builtin_amdgcn_fdot2_f32_bf16(__builtin_bit_cast(bf2_t, a.z), __builtin_bit_cast(bf2_t, hp[2]), s, false);
  s = __builtin_amdgcn_fdot2_f32_bf16(__builtin_bit_cast(bf2_t, a.w), __builtin_bit_cast(bf2_t, hp[3]), s, false);
  s = __builtin_amdgcn_fdot2_f32_bf16(__builtin_bit_cast(bf2_t, b.x), __builtin_bit_cast(bf2_t, hp[4]), s, false);
  s = __builtin_amdgcn_fdot2_f32_bf16(__builtin_bit_cast(bf2_t, b.y), __builtin_bit_cast(bf2_t, hp[5]), s, false);
  s = __builtin_amdgcn_fdot2_f32_bf16(__builtin_bit_cast(bf2_t, b.z), __builtin_bit_cast(bf2_t, hp[6]), s, false);
  s = __builtin_amdgcn_fdot2_f32_bf16(__builtin_bit_cast(bf2_t, b.w), __builtin_bit_cast(bf2_t, hp[7]), s, false);
  return s;
}
__device__ __forceinline__ void axpy16(float (&acc)[16], float hk, uint4 a, uint4 b) {
  acc[0] += hk * bflo(a.x); acc[1] += hk * bfhi(a.x); acc[2] += hk * bflo(a.y); acc[3] += hk * bfhi(a.y);
  acc[4] += hk * bflo(a.z); acc[5] += hk * bfhi(a.z); acc[6] += hk * bflo(a.w); acc[7] += hk * bfhi(a.w);
  acc[8] += hk * bflo(b.x); acc[9] += hk * bfhi(b.x); acc[10] += hk * bflo(b.y); acc[11] += hk * bfhi(b.y);
  acc[12] += hk * bflo(b.z); acc[13] += hk * bfhi(b.z); acc[14] += hk * bflo(b.w); acc[15] += hk * bfhi(b.w);
}

__device__ void phase_gather(const Params& p, int bid, int nb, char* smem) {
  float* tw = (float*)smem;
  float* ts = tw + 2048;
  float* tg = ts + 2048;
  float* tf = tg + 2048;
  const int tid = threadIdx.x, lane = tid & 63, w = tid >> 6;
  for (int i = tid; i < 2048; i += 256) {
    int b = i >> 10, j = i & 1023;
    tw[i] = p.norm2_w[j] * (1.f + p.mod[b * 6144 + 4 * 1024 + j]);
    ts[i] = p.mod[b * 6144 + 3 * 1024 + j];
    tg[i] = p.mod[b * 6144 + 5 * 1024 + j];
  }
  for (int i = tid; i < 1024; i += 256) tf[i] = p.final_w[i];
  __syncthreads();
  const int e0 = lane * 8, e1 = 512 + lane * 8;
  const int GW = nb * 4;
  for (int tok = bid * 4 + w; tok < T; tok += GW) {
    asm volatile("" ::: "memory");
    const int b = tok >> 13;
    const float* xr = p.x1 + (size_t)tok * 1024;
    unsigned hp[8];
    {
      float4 v0 = *(const float4*)(xr + e0), v1 = *(const float4*)(xr + e0 + 4);
      float4 v2 = *(const float4*)(xr + e1), v3 = *(const float4*)(xr + e1 + 4);
      float ss = v0.x * v0.x + v0.y * v0.y + v0.z * v0.z + v0.w * v0.w + v1.x * v1.x + v1.y * v1.y + v1.z * v1.z + v1.w * v1.w +
                 v2.x * v2.x + v2.y * v2.y + v2.z * v2.z + v2.w * v2.w + v3.x * v3.x + v3.y * v3.y + v3.z * v3.z + v3.w * v3.w;
      ss = wave_sum(ss);
      float rstd = rsqrtf(ss * (1.f / 1024.f) + EPS);
      const float* a = tw + b * 1024;
      const float* s = ts + b * 1024;
      float4 a0 = *(const float4*)(a + e0), a1 = *(const float4*)(a + e0 + 4), a2 = *(const float4*)(a + e1), a3 = *(const float4*)(a + e1 + 4);
      float4 s0 = *(const float4*)(s + e0), s1 = *(const float4*)(s + e0 + 4), s2 = *(const float4*)(s + e1), s3 = *(const float4*)(s + e1 + 4);
      hp[0] = pack2(v0.x * rstd * a0.x + s0.x, v0.y * rstd * a0.y + s0.y);
      hp[1] = pack2(v0.z * rstd * a0.z + s0.z, v0.w * rstd * a0.w + s0.w);
      hp[2] = pack2(v1.x * rstd * a1.x + s1.x, v1.y * rstd * a1.y + s1.y);
      hp[3] = pack2(v1.z * rstd * a1.z + s1.z, v1.w * rstd * a1.w + s1.w);
      hp[4] = pack2(v2.x * rstd * a2.x + s2.x, v2.y * rstd * a2.y + s2.y);
      hp[5] = pack2(v2.z * rstd * a2.z + s2.z, v2.w * rstd * a2.w + s2.w);
      hp[6] = pack2(v3.x * rstd * a3.x + s3.x, v3.y * rstd * a3.y + s3.y);
      hp[7] = pack2(v3.z * rstd * a3.z + s3.z, v3.w * rstd * a3.w + s3.w);
    }
    const int ids0 = p.ids[tok * 128 + lane], ids1 = p.ids[tok * 128 + 64 + lane];
    const int gl = 4 * (lane & 15) + (lane >> 4);
    const float gt0 = p.gates[tok * 128 + gl], gt1 = p.gates[tok * 128 + 64 + gl];
    float acc[16];
#pragma unroll
    for (int i = 0; i < 16; i++) acc[i] = 0.f;
    uint4 bA[4], bB[4];
#pragma unroll
    for (int j = 0; j < 4; j++) {
      int id = __builtin_amdgcn_readlane(ids0, j);
      const uint4* ptr = (const uint4*)(p.ub + (size_t)id * 1024) + lane;
      bA[j] = ptr[0]; bB[j] = ptr[64];
    }
    float hid = 0.f;
#pragma unroll 1
    for (int seg = 0; seg < 4; seg++) {
      const bool isv = seg & 1;
      if (!isv) {
        float hv = 0.f;
#pragma unroll 1
        for (int g = 0; g < 16; g++) {
          float part[4];
#pragma unroll
          for (int j = 0; j < 4; j++) {
            part[j] = dot16(bA[j], bB[j], hp);
            int nx = seg * 64 + g * 4 + j + 4;
            int nseg = nx >> 6, nk = nx & 63;
            int id = __builtin_amdgcn_readlane((nseg & 2) ? ids1 : ids0, nk);
            const bf16_t* base = (nseg & 1) ? p.vb : p.ub;
            const uint4* ptr = (const uint4*)(base + (size_t)id * 1024) + lane;
            bA[j] = ptr[0]; bB[j] = ptr[64];
          }
          float r0 = reduce4(part[0], part[1], part[2], part[3]);
          hv = ((lane & 15) == g) ? r0 : hv;
        }
        float gte = (seg & 2) ? gt1 : gt0;
        hid = 0.5f * hv * (1.f + erff(hv * 0.70710678118654752f)) * gte;
      } else {
#pragma unroll 1
        for (int g = 0; g < 16; g++) {
#pragma unroll
          for (int j = 0; j < 4; j++) {
            int k = g * 4 + j;
            float hk = rdlane(hid, (k & 3) * 16 + (k >> 2));
            axpy16(acc, hk, bA[j], bB[j]);
            int nx = (seg * 64 + g * 4 + j + 4) & 255;
            int nseg = nx >> 6, nk = nx & 63;
            int id = __builtin_amdgcn_readlane((nseg & 2) ? ids1 : ids0, nk);
            const bf16_t* base = (nseg & 1) ? p.vb : p.ub;
            const uint4* ptr = (const uint4*)(base + (size_t)id * 1024) + lane;
            bA[j] = ptr[0]; bB[j] = ptr[64];
          }
        }
      }
    }
    asm volatile("" ::: "memory");
    {
      float4 v0 = *(const float4*)(xr + e0), v1 = *(const float4*)(xr + e0 + 4);
      float4 v2 = *(const float4*)(xr + e1), v3 = *(const float4*)(xr + e1 + 4);
      const float* g = tg + b * 1024;
      float4 g0 = *(const float4*)(g + e0), g1 = *(const float4*)(g + e0 + 4), g2 = *(const float4*)(g + e1), g3 = *(const float4*)(g + e1 + 4);
      float y[16];
      y[0] = v0.x + g0.x * acc[0]; y[1] = v0.y + g0.y * acc[1]; y[2] = v0.z + g0.z * acc[2]; y[3] = v0.w + g0.w * acc[3];
      y[4] = v1.x + g1.x * acc[4]; y[5] = v1.y + g1.y * acc[5]; y[6] = v1.z + g1.z * acc[6]; y[7] = v1.w + g1.w * acc[7];
      y[8] = v2.x + g2.x * acc[8]; y[9] = v2.y + g2.y * acc[9]; y[10] = v2.z + g2.z * acc[10]; y[11] = v2.w + g2.w * acc[11];
      y[12] = v3.x + g3.x * acc[12]; y[13] = v3.y + g3.y * acc[13]; y[14] = v3.z + g3.z * acc[14]; y[15] = v3.w + g3.w * acc[15];
      float ss = 0.f;
#pragma unroll
      for (int i = 0; i < 16; i++) ss += y[i] * y[i];
      ss = wave_sum(ss);
      float rstd = rsqrtf(ss * (1.f / 1024.f) + EPS);
      float4 f0 = *(const float4*)(tf + e0), f1 = *(const float4*)(tf + e0 + 4), f2 = *(const float4*)(tf + e1), f3 = *(const float4*)(tf + e1 + 4);
      float* orow = p.out + (size_t)tok * 1024;
      *(float4*)(orow + e0) = make_float4(y[0] * rstd * f0.x, y[1] * rstd * f0.y, y[2] * rstd * f0.z, y[3] * rstd * f0.w);
      *(float4*)(orow + e0 + 4) = make_float4(y[4] * rstd * f1.x, y[5] * rstd * f1.y, y[6] * rstd * f1.z, y[7] * rstd * f1.w);
      *(float4*)(orow + e1) = make_float4(y[8] * rstd * f2.x, y[9] * rstd * f2.y, y[10] * rstd * f2.z, y[11] * rstd * f2.w);
      *(float4*)(orow + e1 + 4) = make_float4(y[12] * rstd * f3.x, y[13] * rstd * f3.y, y[14] * rstd * f3.z, y[15] * rstd * f3.w);
    }
  }
}

template <int PH>
__device__ __forceinline__ void run_phase(const Params& p, int bid, int nb, char* smem) {
  if (PH == 0) phase0(p, bid, nb, smem);
  if (PH == 1) phase_norm<false>(p, bid, nb, smem);
  if (PH == 2) phase_inproj(p, bid, nb, smem);
  if (PH == 3) phase_mix_a(p, bid, nb, smem);
  if (PH == 4) phase_scan(p, bid, nb);
  if (PH == 5) phase_gla_c(p, bid, nb, smem);
  if (PH == 6) phase_outproj(p, bid, nb, smem);
  if (PH == 7) phase_norm<true>(p, bid, nb, smem);
  if (PH == 8) phase_peer_topk(p, bid, nb, smem);
  if (PH == 9) phase_gather(p, bid, nb, smem);
}

#if MULTI
template <int PH>
__global__ void __launch_bounds__(256, 2) phase_kernel(Params p) {
  __shared__ __attribute__((aligned(16))) char smem[SMEM_BYTES];
  run_phase<PH>(p, blockIdx.x, gridDim.x, smem);
}
#else
#define XB_TMO      128
#define XB_XCNT(j)  (256  + 64 * (j))
#define XB_XSUB(j)  (1280 + 64 * (j))
#define XB_XGEN(j)  (2304 + 64 * (j))
#define XB_TOP      3328
#define XB_TOPGEN   3392
#define XCD_BAR_WORDS 3456
#define XB_SPIN_CAP (1u << 22)
#define LAS __attribute__((address_space(3)))
__device__ __forceinline__ unsigned xb_ld(unsigned* p) { return __hip_atomic_load(p, __ATOMIC_RELAXED, __HIP_MEMORY_SCOPE_AGENT); }
__device__ __forceinline__ unsigned xb_add(unsigned* p, unsigned v) { return __hip_atomic_fetch_add(p, v, __ATOMIC_RELAXED, __HIP_MEMORY_SCOPE_AGENT); }
__device__ __forceinline__ unsigned xb_xcc_id() { return (unsigned)__builtin_amdgcn_s_getreg((3 << 11) | 20) & 0xFu; }
#define XB_SPIN(cond, bar) do { unsigned _sp = 0; while (cond) { __builtin_amdgcn_s_sleep(1); \
    if ((++_sp & 255u) == 0u) { if (xb_ld(&(bar)[XB_TMO])) break; if (_sp > XB_SPIN_CAP) { atomicAdd(&(bar)[XB_TMO], 1u); break; } } } } while (0)
struct XcdBarrier { unsigned* bar; unsigned x; volatile LAS unsigned* st; };
__device__ __forceinline__ XcdBarrier xcd_barrier_post(unsigned* bar, volatile LAS unsigned* st) {
  XcdBarrier b; b.bar = bar; b.x = xb_xcc_id(); b.st = st;
  if (threadIdx.x == 0) (void)xb_add(&bar[XB_XCNT(b.x)], 1u);
  return b;
}
__device__ __forceinline__ void xcd_barrier_complete(unsigned* bar, unsigned x, unsigned& nloc, unsigned& nx) {
  const unsigned G = gridDim.x * gridDim.y * gridDim.z;
  unsigned sum, cnt, mine, sp = 0u;
  for (;;) {
    sum = 0u; cnt = 0u; mine = 0u;
#pragma unroll
    for (unsigned j = 0; j < 16; ++j) { const unsigned c = xb_ld(&bar[XB_XCNT(j)]); sum += c; cnt += (c > 0u) ? 1u : 0u; mine = (j == x) ? c : mine; }
    if (sum == G) break;
    __builtin_amdgcn_s_sleep(1);
    if ((++sp & 255u) == 0u) { if (xb_ld(&bar[XB_TMO])) break; if (sp > XB_SPIN_CAP) { atomicAdd(&bar[XB_TMO], 1u); break; } }
  }
  nloc = mine > 0u ? mine : 1u; nx = cnt > 0u ? cnt : 1u;
}
__device__ __forceinline__ void xcd_barrier(const XcdBarrier& b) {
  asm volatile("s_waitcnt vmcnt(0)" ::: "memory");
  __syncthreads();
  if (threadIdx.x == 0) {
    unsigned* bar = b.bar;
    __builtin_amdgcn_s_waitcnt(0);
    unsigned nloc = b.st[0], nx = b.st[1];
    if (nloc == 0u) { xcd_barrier_complete(bar, b.x, nloc, nx); b.st[0] = nloc; b.st[1] = nx; }
    const unsigned old = xb_add(&bar[XB_XSUB(b.x)], 1u);
    const unsigned gen = old / nloc;
    if (old + 1u == (gen + 1u) * nloc) {
      __builtin_amdgcn_fence(__ATOMIC_RELEASE, "agent");
      asm volatile("s_waitcnt vmcnt(0)" ::: "memory");
      const unsigned og = xb_add(&bar[XB_TOP], 1u);
      const unsigned tg = og / nx;
      if (og + 1u == (tg + 1u) * nx) xb_add(&bar[XB_TOPGEN], 1u);
      else XB_SPIN(xb_ld(&bar[XB_TOPGEN]) == tg, bar);
      __builtin_amdgcn_fence(__ATOMIC_ACQUIRE, "agent");
      xb_add(&bar[XB_XGEN(b.x)], 1u);
      asm volatile("s_waitcnt vmcnt(0)" ::: "memory");
    } else {
      XB_SPIN(xb_ld(&bar[XB_XGEN(b.x)]) == gen, bar);
      __builtin_amdgcn_fence(__ATOMIC_ACQUIRE, "agent");
      asm volatile("s_waitcnt vmcnt(0)" ::: "memory");
    }
  }
  __syncthreads();
}

__global__ void __launch_bounds__(256, 2) fwd_megakernel(Params p) {
  __shared__ __attribute__((aligned(16))) char smem[SMEM_BYTES];
  __shared__ uint4 xb_words;
  const int bid = blockIdx.x, nb = gridDim.x;
  if (p.use_cg) cg::this_grid().sync();
  if (threadIdx.x == 0) xb_words = make_uint4(0u, 0u, 0u, 0u);
  __syncthreads();
  XcdBarrier xb = xcd_barrier_post(p.bar, (volatile LAS unsigned*)&xb_words);
  run_phase<0>(p, bid, nb, smem); xcd_barrier(xb);
  run_phase<1>(p, bid, nb, smem); xcd_barrier(xb);
  run_phase<2>(p, bid, nb, smem); xcd_barrier(xb);
  run_phase<3>(p, bid, nb, smem); xcd_barrier(xb);
  run_phase<4>(p, bid, nb, smem); xcd_barrier(xb);
  run_phase<5>(p, bid, nb, smem); xcd_barrier(xb);
  run_phase<6>(p, bid, nb, smem); xcd_barrier(xb);
  run_phase<7>(p, bid, nb, smem); xcd_barrier(xb);
  run_phase<8>(p, bid, nb, smem); xcd_barrier(xb);
  run_phase<9>(p, bid, nb, smem);
}
#endif

extern "C" void kernel_launch(void* const* d_in, const int* in_sizes, int n_in, void* d_out, int out_size, void* d_ws,
                              size_t ws_size, hipStream_t stream) {
  Params p{};
  p.x = (const float*)d_in[0]; p.c = (const float*)d_in[1]; p.w_ada = (const float*)d_in[2]; p.b_ada = (const float*)d_in[3];
  p.norm1_w = (const float*)d_in[4]; p.w_in = (const float*)d_in[5]; p.sinks = (const float*)d_in[6];
  p.gate_up = (const float*)d_in[7]; p.gate_bias = (const float*)d_in[8]; p.gla_norm_w = (const float*)d_in[9];
  p.w_out = (const float*)d_in[10]; p.norm2_w = (const float*)d_in[11]; p.wq = (const float*)d_in[12];
  p.subkeys = (const float*)d_in[13]; p.pu = (const float*)d_in[14]; p.pv = (const float*)d_in[15];
  p.final_w = (const float*)d_in[16];
  p.out = (float*)d_out;
  char* ws = (char*)d_ws;
  size_t off = 0;
  auto take = [&](size_t bytes) { char* q = ws + off; off += (bytes + 255) & ~(size_t)255; return q; };
  p.bar = (unsigned*)take(16384);
  p.modp = (float*)take(4 * 2 * 6144 * 4);
  p.mod = (float*)take(2 * 6144 * 4);
  p.w_inT = (bf16_t*)take((size_t)NPROJ * 1024 * 2);
  p.w_outT = (bf16_t*)take((size_t)1024 * 1024 * 2);
  p.wqT = (bf16_t*)take((size_t)2048 * 1024 * 2);
  p.skb = (bf16_t*)take((size_t)262144 * 2);
  p.ub = (bf16_t*)take((size_t)16384 * 1024 * 2);
  p.vb = (bf16_t*)take((size_t)16384 * 1024 * 2);
  p.hA = (bf16_t*)take((size_t)T * 1024 * 2);
  p.proj = (bf16_t*)take((size_t)T * NPROJ * 2);
  p.x1 = (float*)p.proj;
  p.vT = (bf16_t*)take((size_t)2 * 128 * SEQ * 2);
  p.gvT = (bf16_t*)take((size_t)2 * 512 * SEQ * 2);
  p.stateT = (float*)take((size_t)1024 * 8192 * 4);
  p.ids = (int*)p.stateT;
  p.gates = (float*)((char*)p.stateT + (size_t)T * 128 * 4);
  p.gdec = (float*)take((size_t)1024 * 64 * 4);
  if (off > ws_size) { fprintf(stderr, "workspace too small: need %zu have %zu\n", off, ws_size); return; }

#if MULTI
  const int grid = 512;
  phase_kernel<0><<<grid, 256, 0, stream>>>(p);
  phase_kernel<1><<<grid, 256, 0, stream>>>(p);
  phase_kernel<2><<<grid, 256, 0, stream>>>(p);
  phase_kernel<3><<<grid, 256, 0, stream>>>(p);
  phase_kernel<4><<<grid, 256, 0, stream>>>(p);
  phase_kernel<5><<<grid, 256, 0, stream>>>(p);
  phase_kernel<6><<<grid, 256, 0, stream>>>(p);
  phase_kernel<7><<<grid, 256, 0, stream>>>(p);
  phase_kernel<8><<<grid, 256, 0, stream>>>(p);
  phase_kernel<9><<<grid, 256, 0, stream>>>(p);
#else
  static int grid_blocks = 0;
  if (!grid_blocks) {
    int dev = 0, cus = 0, per_cu = 0;
    hipGetDevice(&dev);
    hipDeviceGetAttribute(&cus, hipDeviceAttributeMultiprocessorCount, dev);
    (void)hipOccupancyMaxActiveBlocksPerMultiprocessor(&per_cu, fwd_megakernel, 256, 0);
    per_cu = 2;
    grid_blocks = cus * per_cu;
  }
  (void)hipMemsetAsync(p.bar, 0, 16384, stream);
  void* args[] = {&p};
  hipError_t e = hipLaunchCooperativeKernel((void*)fwd_megakernel, dim3(grid_blocks), dim3(256), args, 0, stream);
  if (e != hipSuccess) fprintf(stderr, "cooperative launch failed: %s (grid %d)\n", hipGetErrorString(e), grid_blocks);
#endif
}
```

```cpp
#include <hip/hip_runtime.h>
#include <hip/hip_cooperative_groups.h>
#include <stdint.h>
#include <stdio.h>
namespace cg = cooperative_groups;

#ifndef MULTI
#define MULTI 0
#endif

typedef unsigned short bf16_t;
typedef __attribute__((ext_vector_type(8))) short bf16x8;
typedef __attribute__((ext_vector_type(4))) float f32x4;
typedef __attribute__((ext_vector_type(16))) float f32x16;
typedef __attribute__((ext_vector_type(2))) __bf16 bf2_t;
typedef __attribute__((ext_vector_type(2))) float f2_t;

constexpr int T = 16384, DM = 1024, SEQ = 8192;
constexpr int NPROJ = 2432;
constexpr int C_AK = 512, C_AV = 640, C_GQ = 768, C_GK = 1024, C_GV = 1280, C_GG = 1792, C_GLR = 2304;
constexpr float EPS = 1e-6f;
constexpr int SMEM_BYTES = 73728;
constexpr int LDK = 72;

struct Params {
  const float *x, *c, *w_ada, *b_ada, *norm1_w, *w_in, *sinks, *gate_up, *gate_bias, *gla_norm_w,
      *w_out, *norm2_w, *wq, *subkeys, *pu, *pv, *final_w;
  float* out;
  float *modp, *mod;
  bf16_t *w_inT, *w_outT, *wqT, *skb, *hA, *proj, *vT, *gvT;
  unsigned char *ub, *vb;
  float *su, *sv;
  float *stateT, *gdec, *x1;
  int* ids;
  float* gates;
  unsigned* bar;
  int use_cg;
  int pad_;
};

__device__ __forceinline__ unsigned pack2(float a, float b) {
  f2_t v = {a, b};
  bf2_t r = __builtin_convertvector(v, bf2_t);
  return __builtin_bit_cast(unsigned, r);
}
__device__ __forceinline__ bf16_t f2bf(float a) { return (bf16_t)(pack2(a, 0.f) & 0xffffu); }
__device__ __forceinline__ float bf2f(bf16_t h) { return __uint_as_float(((unsigned)h) << 16); }
__device__ __forceinline__ float bflo(unsigned u) { return __uint_as_float(u << 16); }
__device__ __forceinline__ float bfhi(unsigned u) { return __uint_as_float(u & 0xffff0000u); }
__device__ __forceinline__ f32x16 mfma32(bf16x8 a, bf16x8 b, f32x16 c) {
  return __builtin_amdgcn_mfma_f32_32x32x16_bf16(a, b, c, 0, 0, 0);
}
__device__ __forceinline__ f32x16 zero16() {
  f32x16 z;
#pragma unroll
  for (int i = 0; i < 16; i++) z[i] = 0.f;
  return z;
}
__device__ __forceinline__ int rho(int g, int h) { return (g & 3) + 8 * (g >> 2) + 4 * h; }
__device__ __forceinline__ bf16x8 mk8(unsigned a, unsigned b, unsigned c, unsigned d) {
  uint4 u = make_uint4(a, b, c, d);
  return __builtin_bit_cast(bf16x8, u);
}
__device__ __forceinline__ float dpp_add16(float v) {
  v += __int_as_float(__builtin_amdgcn_update_dpp(0, __float_as_int(v), 0xB1, 0xf, 0xf, true));
  v += __int_as_float(__builtin_amdgcn_update_dpp(0, __float_as_int(v), 0x4E, 0xf, 0xf, true));
  v += __int_as_float(__builtin_amdgcn_update_dpp(0, __float_as_int(v), 0x141, 0xf, 0xf, true));
  v += __int_as_float(__builtin_amdgcn_update_dpp(0, __float_as_int(v), 0x140, 0xf, 0xf, true));
  return v;
}
__device__ __forceinline__ float rdlane(float v, int l) {
  return __int_as_float(__builtin_amdgcn_readlane(__float_as_int(v), l));
}
__device__ __forceinline__ float wave_sum(float v) {
  v = dpp_add16(v);
  float a = rdlane(v, 0), b = rdlane(v, 16), c = rdlane(v, 32), d = rdlane(v, 48);
  return (a + b) + (c + d);
}

__device__ void ph_mod(const Params& p, int item, char* smem) {
  float* sm = (float*)smem;
  int cgp = item % 96, kq = item / 96;
  int tid = threadIdx.x, c4 = tid & 15, kg = tid >> 4;
  int col = cgp * 64 + c4 * 4;
  float a0[4] = {0, 0, 0, 0}, a1[4] = {0, 0, 0, 0};
#pragma unroll 4
  for (int i = 0; i < 16; i++) {
    int k = kq * 256 + kg + 16 * i;
    float4 w = *(const float4*)(p.w_ada + (size_t)k * 6144 + col);
    float c0 = p.c[k], c1 = p.c[1024 + k];
    float s0 = c0 / (1.f + __expf(-c0)), s1 = c1 / (1.f + __expf(-c1));
    a0[0] += s0 * w.x; a0[1] += s0 * w.y; a0[2] += s0 * w.z; a0[3] += s0 * w.w;
    a1[0] += s1 * w.x; a1[1] += s1 * w.y; a1[2] += s1 * w.z; a1[3] += s1 * w.w;
  }
#pragma unroll
  for (int j = 0; j < 4; j++) {
    sm[kg * 128 + c4 * 4 + j] = a0[j];
    sm[kg * 128 + 64 + c4 * 4 + j] = a1[j];
  }
  __syncthreads();
  if (tid < 128) {
    float s = 0.f;
#pragma unroll
    for (int g = 0; g < 16; g++) s += sm[g * 128 + tid];
    int b = tid >> 6, cc = tid & 63;
    p.modp[(kq * 2 + b) * 6144 + cgp * 64 + cc] = s;
  }
  __syncthreads();
}

__device__ void ph_transpose(const float* __restrict__ W, int N, bf16_t* __restrict__ out, int kt, int nt, char* smem) {
  float* sm = (float*)smem;
  int tid = threadIdx.x;
  int cn = tid & 63, rk = tid >> 6;
  int n = nt * 64 + cn;
#pragma unroll 4
  for (int i = 0; i < 16; i++) {
    int k = rk + 4 * i;
    float v = (n < N) ? W[(size_t)(kt * 64 + k) * N + n] : 0.f;
    sm[k * 65 + cn] = v;
  }
  __syncthreads();
  int nn = tid >> 2, kc = (tid & 3) * 16;
  unsigned pk[8];
#pragma unroll
  for (int j = 0; j < 8; j++) pk[j] = pack2(sm[(kc + 2 * j) * 65 + nn], sm[(kc + 2 * j + 1) * 65 + nn]);
  uint4* dst = (uint4*)(out + (size_t)(nt * 64 + nn) * 1024 + kt * 64 + kc);
  dst[0] = make_uint4(pk[0], pk[1], pk[2], pk[3]);
  dst[1] = make_uint4(pk[4], pk[5], pk[6], pk[7]);
  __syncthreads();
}

__device__ __forceinline__ void ph_convert(const float* __restrict__ src, bf16_t* __restrict__ dst, int item) {
  size_t off = (size_t)item * 2048 + threadIdx.x * 8;
  float4 a = *(const float4*)(src + off), b = *(const float4*)(src + off + 4);
  *(uint4*)(dst + off) = make_uint4(pack2(a.x, a.y), pack2(a.z, a.w), pack2(b.x, b.y), pack2(b.z, b.w));
}


__device__ __forceinline__ void ph_convert_fp8(const float* __restrict__ src, unsigned char* __restrict__ dst,
                                               float* __restrict__ rinv, int item) {
  const int lane = threadIdx.x & 63, w = threadIdx.x >> 6;
  const int row = item * 4 + w;
  const float* r = src + (size_t)row * 1024 + lane * 16;
  float4 v[4];
  float am = 0.f;
#pragma unroll
  for (int i = 0; i < 4; i++) {
    v[i] = *(const float4*)(r + 4 * i);
    am = fmaxf(am, fmaxf(fmaxf(fabsf(v[i].x), fabsf(v[i].y)), fmaxf(fabsf(v[i].z), fabsf(v[i].w))));
  }
#pragma unroll
  for (int o = 32; o > 0; o >>= 1) am = fmaxf(am, __shfl_xor(am, o));
  int E = (__float_as_int(am) >> 23) & 255;
  E = E < 8 ? 8 : (E > 240 ? 240 : E);
  const float sc = __int_as_float((261 - E) << 23);
  const float inv = __int_as_float((E - 7) << 23);
  unsigned wd[4];
#pragma unroll
  for (int i = 0; i < 4; i++) {
    int t = 0;
    t = __builtin_amdgcn_cvt_pk_fp8_f32(v[i].x * sc, v[i].y * sc, t, false);
    t = __builtin_amdgcn_cvt_pk_fp8_f32(v[i].z * sc, v[i].w * sc, t, true);
    wd[i] = (unsigned)t;
  }
  *(uint4*)(dst + (size_t)row * 1024 + lane * 16) = make_uint4(wd[0], wd[1], wd[2], wd[3]);
  if (lane == 0) rinv[row] = inv;
}

__device__ void phase0(const Params& p, int bid, int nb, char* smem) {
  constexpr int N_MOD = 384, N_TIN = 16 * 38, N_TOUT = 16 * 16, N_TQ = 16 * 32;
  constexpr int N_SK = 128, N_U = 4096;
  constexpr int TOTAL = N_MOD + N_TIN + N_TOUT + N_TQ + N_SK + 2 * N_U;
  for (int it = bid; it < TOTAL; it += nb) {
    int i = it;
    if (i < N_MOD) { ph_mod(p, i, smem); continue; }
    i -= N_MOD;
    if (i < N_TIN) { ph_transpose(p.w_in, 2320, p.w_inT, i & 15, i >> 4, smem); continue; }
    i -= N_TIN;
    if (i < N_TOUT) { ph_transpose(p.w_out, 1024, p.w_outT, i & 15, i >> 4, smem); continue; }
    i -= N_TOUT;
    if (i < N_TQ) { ph_transpose(p.wq, 2048, p.wqT, i & 15, i >> 4, smem); continue; }
    i -= N_TQ;
    if (i < N_SK) { ph_convert(p.subkeys, p.skb, i); continue; }
    i -= N_SK;
    if (i < N_U) { ph_convert_fp8(p.pu, p.ub, p.su, i); continue; }
    i -= N_U;
    ph_convert_fp8(p.pv, p.vb, p.sv, i);
  }
}

template <bool SECOND>
__device__ void phase_norm(const Params& p, int bid, int nb, char* smem) {
  float* tw = (float*)smem;
  float* ts = tw + 1024;
  const int tid = threadIdx.x, lane = tid & 63, w = tid >> 6;
  const float* src = SECOND ? p.x1 : p.x;
  const float* nw = SECOND ? p.norm2_w : p.norm1_w;
  for (int item = bid; item < 256; item += nb) {
    int b = item >> 7;
    if (!SECOND) {
      if (item < 48) {
        int j = item * 256 + tid;
        int bb = j / 6144, jj = j % 6144;
        float s = p.b_ada[jj];
#pragma unroll
        for (int q = 0; q < 4; q++) s += p.modp[(q * 2 + bb) * 6144 + jj];
        p.mod[j] = s;
      }
      for (int j = tid; j < 1024; j += 256) {
        float sc = p.b_ada[1024 + j], sh = p.b_ada[j];
#pragma unroll
        for (int q = 0; q < 4; q++) {
          sc += p.modp[(q * 2 + b) * 6144 + 1024 + j];
          sh += p.modp[(q * 2 + b) * 6144 + j];
        }
        tw[j] = nw[j] * (1.f + sc);
        ts[j] = sh;
      }
    } else {
      for (int j = tid; j < 1024; j += 256) {
        tw[j] = nw[j] * (1.f + p.mod[b * 6144 + 4 * 1024 + j]);
        ts[j] = p.mod[b * 6144 + 3 * 1024 + j];
      }
    }
    __syncthreads();
    for (int tt = 0; tt < 16; tt++) {
      int tok = item * 64 + w * 16 + tt;
      const float* xr = src + (size_t)tok * 1024;
      float4 v[4];
      float ss = 0.f;
#pragma unroll
      for (int i = 0; i < 4; i++) {
        v[i] = *(const float4*)(xr + lane * 4 + 256 * i);
        ss += v[i].x * v[i].x + v[i].y * v[i].y + v[i].z * v[i].z + v[i].w * v[i].w;
      }
      ss = wave_sum(ss);
      float rstd = rsqrtf(ss * (1.f / 1024.f) + EPS);
#pragma unroll
      for (int i = 0; i < 4; i++) {
        int e = lane * 4 + 256 * i;
        float4 a = *(const float4*)(tw + e), s = *(const float4*)(ts + e);
        float o0 = v[i].x * rstd * a.x + s.x, o1 = v[i].y * rstd * a.y + s.y;
        float o2 = v[i].z * rstd * a.z + s.z, o3 = v[i].w * rstd * a.w + s.w;
        *(uint2*)(p.hA + (size_t)tok * 1024 + e) = make_uint2(pack2(o0, o1), pack2(o2, o3));
      }
    }
    __syncthreads();
  }
}

__device__ __forceinline__ void gemm_mainloop(const bf16_t* __restrict__ Wt, const bf16_t* __restrict__ Xa,
                                              int n0, int t0, char* smem, f32x16 (&acc)[2][2]) {
  const int tid = threadIdx.x, lane = tid & 63, w = tid >> 6, wn = w >> 1, wt = w & 1;
  const int r = lane & 31, h = lane >> 5;
  bf16_t* sW = (bf16_t*)smem;
  bf16_t* sX = sW + 2 * 128 * LDK;
  uint4 rw[4], rx[4];
  const bf16_t* gW = Wt + (size_t)(n0 + (tid >> 3)) * 1024 + (tid & 7) * 8;
  const bf16_t* gX = Xa + (size_t)(t0 + (tid >> 3)) * 1024 + (tid & 7) * 8;
  const int soff = (tid >> 3) * LDK + (tid & 7) * 8;
#pragma unroll
  for (int i = 0; i < 2; i++)
#pragma unroll
    for (int j = 0; j < 2; j++) acc[i][j] = zero16();
#pragma unroll
  for (int i = 0; i < 4; i++) {
    rw[i] = *(const uint4*)(gW + (size_t)i * 32 * 1024);
    rx[i] = *(const uint4*)(gX + (size_t)i * 32 * 1024);
  }
#pragma unroll
  for (int i = 0; i < 4; i++) {
    *(uint4*)(sW + soff + i * 32 * LDK) = rw[i];
    *(uint4*)(sX + soff + i * 32 * LDK) = rx[i];
  }
  __syncthreads();
  for (int kt = 0; kt < 16; kt++) {
    if (kt + 1 < 16) {
#pragma unroll
      for (int i = 0; i < 4; i++) {
        rw[i] = *(const uint4*)(gW + (size_t)i * 32 * 1024 + (kt + 1) * 64);
        rx[i] = *(const uint4*)(gX + (size_t)i * 32 * 1024 + (kt + 1) * 64);
      }
    }
    const bf16_t* bW = sW + (kt & 1) * 128 * LDK + (64 * wn + r) * LDK + h * 8;
    const bf16_t* bX = sX + (kt & 1) * 128 * LDK + (64 * wt + r) * LDK + h * 8;
#pragma unroll
    for (int s = 0; s < 4; s++) {
      bf16x8 aw[2], bx[2];
#pragma unroll
      for (int i = 0; i < 2; i++) aw[i] = *(const bf16x8*)(bW + i * 32 * LDK + s * 16);
#pragma unroll
      for (int j = 0; j < 2; j++) bx[j] = *(const bf16x8*)(bX + j * 32 * LDK + s * 16);
#pragma unroll
      for (int i = 0; i < 2; i++)
#pragma unroll
        for (int j = 0; j < 2; j++) acc[i][j] = mfma32(aw[i], bx[j], acc[i][j]);
    }
    if (kt + 1 < 16) {
      const int bo = ((kt + 1) & 1) * 128 * LDK;
#pragma unroll
      for (int i = 0; i < 4; i++) {
        *(uint4*)(sW + bo + soff + i * 32 * LDK) = rw[i];
        *(uint4*)(sX + bo + soff + i * 32 * LDK) = rx[i];
      }
    }
    __syncthreads();
  }
}

__device__ void phase_inproj(const Params& p, int bid, int nb, char* smem) {
  const int tid = threadIdx.x, lane = tid & 63, w = tid >> 6, wn = w >> 1, wt = w & 1;
  const int r = lane & 31, h = lane >> 5;
  for (int item = bid; item < 19 * 128; item += nb) {
    int ntile = item % 19, ttile = item / 19;
    int n0 = ntile * 128, t0 = ttile * 128;
    f32x16 acc[2][2];
    gemm_mainloop(p.w_inT, p.hA, n0, t0, smem, acc);
    const bool isAV = (ntile == 5), isGV = (ntile >= 10 && ntile < 14);
#pragma unroll
    for (int i = 0; i < 2; i++)
#pragma unroll
      for (int j = 0; j < 2; j++) {
        int tok = t0 + 64 * wt + 32 * j + r;
        if (isAV || isGV) {
          int b = tok >> 13, s = tok & 8191;
#pragma unroll
          for (int g = 0; g < 16; g++) {
            int n = n0 + 64 * wn + 32 * i + rho(g, h);
            bf16_t v = f2bf(acc[i][j][g]);
            if (isAV) p.vT[((size_t)(b * 128 + (n - C_AV))) * SEQ + s] = v;
            else p.gvT[((size_t)(b * 512 + (n - C_GV))) * SEQ + s] = v;
          }
        } else {
#pragma unroll
          for (int gg = 0; gg < 4; gg++) {
            int n = n0 + 64 * wn + 32 * i + 8 * gg + 4 * h;
            *(uint2*)(p.proj + (size_t)tok * NPROJ + n) =
                make_uint2(pack2(acc[i][j][4 * gg], acc[i][j][4 * gg + 1]), pack2(acc[i][j][4 * gg + 2], acc[i][j][4 * gg + 3]));
          }
        }
      }
  }
}

__device__ void ph_attn(const Params& p, int item) {
  const int tid = threadIdx.x, lane = tid & 63, w = tid >> 6, r = lane & 31, h = lane >> 5;
  const int hq = item & 7, nblk = (item >> 3) & 63, b = item >> 9, kvh = hq >> 2;
  const int q_tok = b * SEQ + nblk * 128 + 32 * w + r;
  bf16x8 qf[4];
#pragma unroll
  for (int s = 0; s < 4; s++) qf[s] = *(const bf16x8*)(p.proj + (size_t)q_tok * NPROJ + hq * 64 + s * 16 + h * 8);
  f32x16 sa[5];
#pragma unroll
  for (int tt = 0; tt < 5; tt++) {
    int kpos = (nblk - 1) * 128 + 32 * (w + tt) + r;
    kpos = kpos < 0 ? 0 : kpos;
    const bf16_t* kptr = p.proj + (size_t)(b * SEQ + kpos) * NPROJ + C_AK + kvh * 64 + h * 8;
    sa[tt] = zero16();
#pragma unroll
    for (int s = 0; s < 4; s++) {
      bf16x8 kf = *(const bf16x8*)(kptr + s * 16);
      sa[tt] = mfma32(kf, qf[s], sa[tt]);
    }
  }
  const float L2E = 1.4426950408889634f;
  const float sc = 0.125f * L2E;
  const float sinkt = p.sinks[hq] * L2E;
  float m = sinkt;
#pragma unroll
  for (int tt = 0; tt < 5; tt++)
#pragma unroll
    for (int g = 0; g < 16; g++) {
      int rr = rho(g, h);
      int d = 32 * tt + rr - r;
      bool valid = (d >= 1) && (d <= 128) && (nblk > 0 || (32 * (w + tt) + rr) >= 128);
      float v = valid ? sa[tt][g] * sc : -INFINITY;
      sa[tt][g] = v;
      m = fmaxf(m, v);
    }
  m = fmaxf(m, __shfl_xor(m, 32));
  float sum = 0.f;
#pragma unroll
  for (int tt = 0; tt < 5; tt++)
#pragma unroll
    for (int g = 0; g < 16; g++) {
      float e = exp2f(sa[tt][g] - m);
      sa[tt][g] = e;
      sum += e;
    }
  sum += __shfl_xor(sum, 32);
  sum += exp2f(sinkt - m);
  const float inv = 1.f / sum;
  f32x16 o[2];
  o[0] = zero16(); o[1] = zero16();
#pragma unroll
  for (int tt = 0; tt < 5; tt++)
#pragma unroll
    for (int s2 = 0; s2 < 2; s2++) {
      bf16x8 pf = mk8(pack2(sa[tt][8 * s2 + 0], sa[tt][8 * s2 + 1]), pack2(sa[tt][8 * s2 + 2], sa[tt][8 * s2 + 3]),
                      pack2(sa[tt][8 * s2 + 4], sa[tt][8 * s2 + 5]), pack2(sa[tt][8 * s2 + 6], sa[tt][8 * s2 + 7]));
      int kb = (nblk - 1) * 128 + 32 * (w + tt) + 16 * s2 + 4 * h;
      kb = kb < 0 ? 0 : kb;
#pragma unroll
      for (int mt = 0; mt < 2; mt++) {
        const bf16_t* vp = p.vT + ((size_t)(b * 128 + kvh * 64 + 32 * mt + r)) * SEQ + kb;
        uint2 lo = *(const uint2*)vp, hi = *(const uint2*)(vp + 8);
        o[mt] = mfma32(mk8(lo.x, lo.y, hi.x, hi.y), pf, o[mt]);
      }
    }
#pragma unroll
  for (int mt = 0; mt < 2; mt++)
#pragma unroll
    for (int gg = 0; gg < 4; gg++) {
      int d0 = 32 * mt + 8 * gg + 4 * h;
      *(uint2*)(p.hA + (size_t)q_tok * 1024 + hq * 64 + d0) =
          make_uint2(pack2(o[mt][4 * gg] * inv, o[mt][4 * gg + 1] * inv), pack2(o[mt][4 * gg + 2] * inv, o[mt][4 * gg + 3] * inv));
    }
}

__device__ __forceinline__ void gla_decay(const Params& p, int b, int hh, int c, char* smem, float (&bl)[16], float& blast) {
  float* sglr = (float*)smem;
  float* sgrp = sglr + 1024;
  const int tid = threadIdx.x, d = tid & 63, tq = tid >> 6;
  const int tok0 = b * SEQ + c * 64;
  {
    int idx = tid * 4, t = idx >> 4, rr = idx & 15;
    uint2 u = *(const uint2*)(p.proj + (size_t)(tok0 + t) * NPROJ + C_GLR + rr);
    sglr[idx] = bflo(u.x); sglr[idx + 1] = bfhi(u.x); sglr[idx + 2] = bflo(u.y); sglr[idx + 3] = bfhi(u.y);
  }
  float gu[16];
#pragma unroll
  for (int rr = 0; rr < 16; rr++) gu[rr] = p.gate_up[rr * 256 + hh * 64 + d];
  const float bias = p.gate_bias[hh * 64 + d];
  __syncthreads();
  float run = 0.f;
#pragma unroll
  for (int i = 0; i < 16; i++) {
    int t = tq * 16 + i;
    float z = bias;
#pragma unroll
    for (int q = 0; q < 4; q++) {
      float4 g4 = *(const float4*)(sglr + t * 16 + q * 4);
      z += g4.x * gu[q * 4] + g4.y * gu[q * 4 + 1] + g4.z * gu[q * 4 + 2] + g4.w * gu[q * 4 + 3];
    }
    float la = (fminf(z, 0.f) - __logf(1.f + __expf(-fabsf(z)))) * (1.f / 16.f);
    run += la;
    bl[i] = run;
  }
  sgrp[tq * 64 + d] = run;
  __syncthreads();
  float off = 0.f, tot = 0.f;
#pragma unroll
  for (int q = 0; q < 4; q++) {
    float v = sgrp[q * 64 + d];
    tot += v;
    off += (q < tq) ? v : 0.f;
  }
#pragma unroll
  for (int i = 0; i < 16; i++) bl[i] += off;
  blast = tot;
}

__device__ void ph_gla_a(const Params& p, int item, char* smem) {
  const int tid = threadIdx.x, lane = tid & 63, w = tid >> 6, r = lane & 31, h = lane >> 5;
  const int d = tid & 63, tq = tid >> 6;
  const int c = item & 127, hh = (item >> 7) & 3, b = item >> 9;
  const int tok0 = b * SEQ + c * 64;
  float bl[16], blast;
  gla_decay(p, b, hh, c, smem, bl, blast);
  bf16_t* k2T = (bf16_t*)(smem + 8192);
  unsigned pk[8];
#pragma unroll
  for (int i = 0; i < 8; i++) {
    int t0 = tq * 16 + 2 * i;
    float k0 = bf2f(p.proj[(size_t)(tok0 + t0) * NPROJ + C_GK + hh * 64 + d]);
    float k1 = bf2f(p.proj[(size_t)(tok0 + t0 + 1) * NPROJ + C_GK + hh * 64 + d]);
    pk[i] = pack2(k0 * __expf(blast - bl[2 * i]), k1 * __expf(blast - bl[2 * i + 1]));
  }
  *(uint4*)(k2T + d * LDK + tq * 16) = make_uint4(pk[0], pk[1], pk[2], pk[3]);
  *(uint4*)(k2T + d * LDK + tq * 16 + 8) = make_uint4(pk[4], pk[5], pk[6], pk[7]);
  if (tq == 0) p.gdec[item * 64 + d] = __expf(blast);
  __syncthreads();
  f32x16 acc[2];
  acc[0] = zero16(); acc[1] = zero16();
  const bf16_t* vrow = p.gvT + ((size_t)(b * 512 + hh * 128 + 32 * w + r)) * SEQ + c * 64 + 8 * h;
#pragma unroll
  for (int s = 0; s < 4; s++) {
    bf16x8 av = *(const bf16x8*)(vrow + 16 * s);
#pragma unroll
    for (int nt = 0; nt < 2; nt++) {
      bf16x8 bk = *(const bf16x8*)(k2T + (32 * nt + r) * LDK + 16 * s + 8 * h);
      acc[nt] = mfma32(av, bk, acc[nt]);
    }
  }
  float* st = p.stateT + (size_t)item * 8192;
#pragma unroll
  for (int nt = 0; nt < 2; nt++)
#pragma unroll
    for (int g = 0; g < 16; g++) st[(32 * w + rho(g, h)) * 64 + 32 * nt + r] = acc[nt][g];
  __syncthreads();
}

__device__ void phase_mix_a(const Params& p, int bid, int nb, char* smem) {
  for (int it = bid; it < 2048; it += nb) {
    if (it < 1024) ph_gla_a(p, it, smem);
    else ph_attn(p, it - 1024);
  }
}

__device__ void phase_scan(const Params& p, int bid, int nb) {
  for (int it = bid; it < 256; it += nb) {
    int bh = it >> 5, e = (it & 31) * 256 + threadIdx.x, dk = e & 63;
    float st = 0.f;
    for (int c0 = 0; c0 < 128; c0 += 16) {
      float sl[16], gd[16];
#pragma unroll
      for (int j = 0; j < 16; j++) {
        sl[j] = p.stateT[(size_t)(bh * 128 + c0 + j) * 8192 + e];
        gd[j] = p.gdec[(bh * 128 + c0 + j) * 64 + dk];
      }
#pragma unroll
      for (int j = 0; j < 16; j++) {
        p.stateT[(size_t)(bh * 128 + c0 + j) * 8192 + e] = st;
        st = gd[j] * st + sl[j];
      }
    }
  }
}

__device__ void phase_gla_c(const Params& p, int bid, int nb, char* smem) {
  const int tid = threadIdx.x, lane = tid & 63, w = tid >> 6, r = lane & 31, h = lane >> 5;
  const int d = tid & 63, tq = tid >> 6;
  bf16_t* qs = (bf16_t*)(smem + 8192);
  bf16_t* ks = qs + 64 * LDK;
  float* sred = (float*)(smem + 8192 + 2 * 64 * LDK * 2);
  for (int item = bid; item < 1024; item += nb) {
    const int c = item & 127, hh = (item >> 7) & 3, b = item >> 9;
    const int tok0 = b * SEQ + c * 64;
    float bl[16], blast;
    gla_decay(p, b, hh, c, smem, bl, blast);
#pragma unroll
    for (int i = 0; i < 16; i++) {
      int t = tq * 16 + i;
      const bf16_t* pr = p.proj + (size_t)(tok0 + t) * NPROJ + hh * 64 + d;
      float qv = bf2f(pr[C_GQ]), kv = bf2f(pr[C_GK]);
      qs[t * LDK + d] = f2bf(qv * 0.125f * __expf(bl[i]));
      ks[t * LDK + d] = f2bf(kv * __expf(-bl[i]));
    }
    __syncthreads();
    const int tt = w & 1, dvh = w >> 1;
    f32x16 at[2];
    at[0] = zero16(); at[1] = zero16();
#pragma unroll
    for (int s = 0; s < 4; s++) {
      bf16x8 bq = *(const bf16x8*)(qs + (32 * tt + r) * LDK + 16 * s + 8 * h);
      bf16x8 a0 = *(const bf16x8*)(ks + r * LDK + 16 * s + 8 * h);
      at[0] = mfma32(a0, bq, at[0]);
      if (tt == 1) {
        bf16x8 a1 = *(const bf16x8*)(ks + (32 + r) * LDK + 16 * s + 8 * h);
        at[1] = mfma32(a1, bq, at[1]);
      }
    }
#pragma unroll
    for (int g = 0; g < 16; g++) {
      int rr = rho(g, h);
      if (tt == 0) { if (rr > r) at[0][g] = 0.f; }
      else { if (rr > r) at[1][g] = 0.f; }
    }
    f32x16 o[2];
    o[0] = zero16(); o[1] = zero16();
#pragma unroll
    for (int st = 0; st < 2; st++) {
      if (st <= tt) {
#pragma unroll
        for (int s2 = 0; s2 < 2; s2++) {
          bf16x8 pf = mk8(pack2(at[st][8 * s2 + 0], at[st][8 * s2 + 1]), pack2(at[st][8 * s2 + 2], at[st][8 * s2 + 3]),
                          pack2(at[st][8 * s2 + 4], at[st][8 * s2 + 5]), pack2(at[st][8 * s2 + 6], at[st][8 * s2 + 7]));
#pragma unroll
          for (int m2 = 0; m2 < 2; m2++) {
            int mt = 2 * dvh + m2;
            const bf16_t* vp = p.gvT + ((size_t)(b * 512 + hh * 128 + 32 * mt + r)) * SEQ + c * 64 + 32 * st + 16 * s2 + 4 * h;
            uint2 lo = *(const uint2*)vp, hi = *(const uint2*)(vp + 8);
            o[m2] = mfma32(mk8(lo.x, lo.y, hi.x, hi.y), pf, o[m2]);
          }
        }
      }
    }
    const float* stp = p.stateT + (size_t)item * 8192;
#pragma unroll
    for (int s = 0; s < 4; s++) {
      bf16x8 bq = *(const bf16x8*)(qs + (32 * tt + r) * LDK + 16 * s + 8 * h);
#pragma unroll
      for (int m2 = 0; m2 < 2; m2++) {
        int mt = 2 * dvh + m2;
        const float* sp = stp + (32 * mt + r) * 64 + 16 * s + 8 * h;
        float4 f0 = *(const float4*)sp, f1 = *(const float4*)(sp + 4);
        o[m2] = mfma32(mk8(pack2(f0.x, f0.y), pack2(f0.z, f0.w), pack2(f1.x, f1.y), pack2(f1.z, f1.w)), bq, o[m2]);
      }
    }
    float ss = 0.f;
#pragma unroll
    for (int m2 = 0; m2 < 2; m2++)
#pragma unroll
      for (int g = 0; g < 16; g++) ss += o[m2][g] * o[m2][g];
    ss += __shfl_xor(ss, 32);
    if (h == 0) sred[dvh * 64 + 32 * tt + r] = ss;
    __syncthreads();
    float tot = sred[32 * tt + r] + sred[64 + 32 * tt + r];
    float rstd = rsqrtf(tot * (1.f / 128.f) + EPS);
    const int tok = tok0 + 32 * tt + r;
#pragma unroll
    for (int m2 = 0; m2 < 2; m2++)
#pragma unroll
      for (int gg = 0; gg < 4; gg++) {
        int dv0 = 32 * (2 * dvh + m2) + 8 * gg + 4 * h;
        uint2 gu = *(const uint2*)(p.proj + (size_t)tok * NPROJ + C_GG + hh * 128 + dv0);
        float4 nw = *(const float4*)(p.gla_norm_w + dv0);
        float g0 = bflo(gu.x), g1 = bfhi(gu.x), g2 = bflo(gu.y), g3 = bfhi(gu.y);
        float r0 = o[m2][4 * gg] * rstd * nw.x * (g0 / (1.f + __expf(-g0)));
        float r1 = o[m2][4 * gg + 1] * rstd * nw.y * (g1 / (1.f + __expf(-g1)));
        float r2 = o[m2][4 * gg + 2] * rstd * nw.z * (g2 / (1.f + __expf(-g2)));
        float r3 = o[m2][4 * gg + 3] * rstd * nw.w * (g3 / (1.f + __expf(-g3)));
        *(uint2*)(p.hA + (size_t)tok * 1024 + 512 + hh * 128 + dv0) = make_uint2(pack2(r0, r1), pack2(r2, r3));
      }
    __syncthreads();
  }
}

__device__ void phase_outproj(const Params& p, int bid, int nb, char* smem) {
  const int tid = threadIdx.x, lane = tid & 63, w = tid >> 6, wn = w >> 1, wt = w & 1;
  const int r = lane & 31, h = lane >> 5;
  for (int item = bid; item < 8 * 128; item += nb) {
    int ntile = item & 7, ttile = item >> 3;
    int n0 = ntile * 128, t0 = ttile * 128;
    int b = t0 >> 13;
    f32x16 acc[2][2];
    gemm_mainloop(p.w_outT, p.hA, n0, t0, smem, acc);
    const float* g1 = p.mod + b * 6144 + 2 * 1024;
#pragma unroll
    for (int i = 0; i < 2; i++)
#pragma unroll
      for (int j = 0; j < 2; j++) {
        int tok = t0 + 64 * wt + 32 * j + r;
#pragma unroll
        for (int gg = 0; gg < 4; gg++) {
          int n = n0 + 64 * wn + 32 * i + 8 * gg + 4 * h;
          float4 xv = *(const float4*)(p.x + (size_t)tok * 1024 + n);
          float4 gv = *(const float4*)(g1 + n);
          float4 ov;
          ov.x = xv.x + gv.x * acc[i][j][4 * gg];
          ov.y = xv.y + gv.y * acc[i][j][4 * gg + 1];
          ov.z = xv.z + gv.z * acc[i][j][4 * gg + 2];
          ov.w = xv.w + gv.w * acc[i][j][4 * gg + 3];
          *(float4*)(p.x1 + (size_t)tok * 1024 + n) = ov;
        }
      }
  }
}

__device__ __forceinline__ int fkey(float f) {
  int b = __float_as_int(f);
  return b ^ ((b >> 31) & 0x7fffffff);
}
__device__ __forceinline__ float kfloat(int k) { return __int_as_float(k ^ ((k >> 31) & 0x7fffffff)); }

__device__ __forceinline__ void bitonic_sort16(int (&a)[16]) {
#pragma unroll
  for (int k = 2; k <= 16; k <<= 1) {
#pragma unroll
    for (int j = k >> 1; j > 0; j >>= 1) {
#pragma unroll
      for (int i = 0; i < 16; i++) {
        int l = i ^ j;
        if (l > i) {
          bool up = ((i & k) == 0) || (k == 16);
          int mx = max(a[i], a[l]), mn = min(a[i], a[l]);
          a[i] = up ? mx : mn;
          a[l] = up ? mn : mx;
        }
      }
    }
  }
}
__device__ __forceinline__ void bitonic_merge16(int (&a)[16]) {
#pragma unroll
  for (int j = 8; j > 0; j >>= 1) {
#pragma unroll
    for (int i = 0; i < 16; i++) {
      int l = i ^ j;
      if (l > i) {
        int mx = max(a[i], a[l]), mn = min(a[i], a[l]);
        a[i] = mx; a[l] = mn;
      }
    }
  }
}
__device__ __forceinline__ void merge_top16(int (&a)[16], const int (&b)[16]) {
#pragma unroll
  for (int i = 0; i < 16; i++) a[i] = max(a[i], b[15 - i]);
  bitonic_merge16(a);
}

struct PairTab { int pi[64], pj[64]; };
__host__ __device__ constexpr PairTab make_pairs() {
  PairTab t{};
  int n = 0;
  for (int i = 0; i < 16; i++)
    for (int j = 0; j < 16; j++)
      if ((i + 1) * (j + 1) <= 16) { t.pi[n] = i; t.pj[n] = j; n++; }
  for (; n < 64; n++) { t.pi[n] = -1; t.pj[n] = -1; }
  return t;
}

__device__ void phase_peer_topk(const Params& p, int bid, int nb, char* smem) {
  const int tid = threadIdx.x, lane = tid & 63, w = tid >> 6, wn = w >> 1, wt = w & 1;
  const int r = lane & 31, h = lane >> 5;
  constexpr int LDQ = 136;
  bf16_t* sQ = (bf16_t*)smem;
  int* slst = (int*)(smem + 40960) + w * (32 * 33);
  for (int item = bid; item < 1024; item += nb) {
    const int hh = item & 7, t0 = (item >> 3) * 128;
    int L[2][16];
#pragma unroll
    for (int pp = 0; pp < 2; pp++) {
      f32x16 acc[2][2];
      gemm_mainloop(p.wqT, p.hA, hh * 256 + pp * 128, t0, smem, acc);
#pragma unroll
      for (int i = 0; i < 2; i++)
#pragma unroll
        for (int j = 0; j < 2; j++)
#pragma unroll
          for (int gg = 0; gg < 4; gg++) {
            int tl = 64 * wt + 32 * j + r, qc = 64 * wn + 32 * i + 8 * gg + 4 * h;
            *(uint2*)(sQ + tl * LDQ + qc) =
                make_uint2(pack2(acc[i][j][4 * gg], acc[i][j][4 * gg + 1]), pack2(acc[i][j][4 * gg + 2], acc[i][j][4 * gg + 3]));
          }
      __syncthreads();
      f32x16 sc[4];
#pragma unroll
      for (int m = 0; m < 4; m++) sc[m] = zero16();
      const bf16_t* skp = p.skb + (size_t)((hh * 2 + pp) * 128 + r) * 128 + 8 * h;
#pragma unroll
      for (int s = 0; s < 8; s++) {
        bf16x8 bq = *(const bf16x8*)(sQ + (32 * w + r) * LDQ + 16 * s + 8 * h);
#pragma unroll
        for (int m = 0; m < 4; m++) {
          bf16x8 ak = *(const bf16x8*)(skp + (size_t)(32 * m) * 128 + 16 * s);
          sc[m] = mfma32(ak, bq, sc[m]);
        }
      }
      int A[16], Bv[16];
#pragma unroll
      for (int m = 0; m < 4; m++) {
        int* dst = (m == 0) ? A : Bv;
#pragma unroll
        for (int g = 0; g < 16; g++) {
          int code = 127 ^ (32 * m + (g & 3) + 8 * (g >> 2));
          dst[g] = ((fkey(sc[m][g]) & ~127) | code) ^ (4 * h);
        }
        bitonic_sort16(dst == A ? A : Bv);
        if (m > 0) merge_top16(A, Bv);
      }
#pragma unroll
      for (int i = 0; i < 16; i++) Bv[i] = __shfl_xor(A[i], 32);
      merge_top16(A, Bv);
#pragma unroll
      for (int i = 0; i < 16; i++) L[pp][i] = A[i];
      __syncthreads();
    }
    constexpr PairTab PT = make_pairs();
    float f0[16], f1[16];
#pragma unroll
    for (int i = 0; i < 16; i++) { f0[i] = kfloat(L[0][i]); f1[i] = kfloat(L[1][i]); }
    int G0[16], G1[16];
#pragma unroll
    for (int q = 0; q < 4; q++) {
      int* dst = (q == 0) ? G0 : G1;
#pragma unroll
      for (int i = 0; i < 16; i++) {
        int cidx = q * 16 + i;
        if (PT.pi[cidx] >= 0) {
          float sv = f0[PT.pi[cidx] < 0 ? 0 : PT.pi[cidx]] + f1[PT.pj[cidx] < 0 ? 0 : PT.pj[cidx]];
          dst[i] = (fkey(sv) & ~255) | (PT.pi[cidx] << 4) | PT.pj[cidx];
        } else {
          dst[i] = (int)0x80000000;
        }
      }
      bitonic_sort16(dst == G0 ? G0 : G1);
      if (q > 0) merge_top16(G0, G1);
    }
    if (h == 0) {
#pragma unroll
      for (int i = 0; i < 16; i++) { slst[r * 33 + i] = L[0][i]; slst[r * 33 + 16 + i] = L[1][i]; }
    }
    __builtin_amdgcn_wave_barrier();
    __syncthreads();
    float vals[16], mx = -INFINITY;
    int eid[16];
#pragma unroll
    for (int k = 0; k < 16; k++) {
      int key = G0[k];
      int ci = (key >> 4) & 15, cj = key & 15;
      int k0 = slst[r * 33 + ci], k1 = slst[r * 33 + 16 + cj];
      eid[k] = (127 - (k0 & 127)) * 128 + (127 - (k1 & 127));
      vals[k] = kfloat(key);
      mx = fmaxf(mx, vals[k]);
    }
    float sum = 0.f;
#pragma unroll
    for (int k = 0; k < 16; k++) { vals[k] = __expf(vals[k] - mx); sum += vals[k]; }
    float inv = 1.f / sum;
    const int tok = t0 + 32 * w + r;
    if (h == 0) {
#pragma unroll
      for (int k = 0; k < 8; k++) { p.ids[tok * 128 + hh * 16 + k] = eid[k]; p.gates[tok * 128 + hh * 16 + k] = vals[k] * inv; }
    } else {
#pragma unroll
      for (int k = 8; k < 16; k++) { p.ids[tok * 128 + hh * 16 + k] = eid[k]; p.gates[tok * 128 + hh * 16 + k] = vals[k] * inv; }
    }
    __syncthreads();
  }
}

__device__ __forceinline__ float reduce4(float p0, float p1, float p2, float p3) {
  auto s02 = __builtin_amdgcn_permlane32_swap(__float_as_uint(p0), __float_as_uint(p2), false, false);
  auto s13 = __builtin_amdgcn_permlane32_swap(__float_as_uint(p1), __float_as_uint(p3), false, false);
  float a = __uint_as_float(s02[0]) + __uint_as_float(s02[1]);
  float b = __uint_as_float(s13[0]) + __uint_as_float(s13[1]);
  auto t = __builtin_amdgcn_permlane16_swap(__float_as_uint(a), __float_as_uint(b), false, false);
  float c = __uint_as_float(t[0]) + __uint_as_float(t[1]);
  return dpp_add16(c);
}
__device__ __forceinline__ float dot16f8(uint4 a, const float (&hf)[16]) {
  f2_t d0 = __builtin_amdgcn_cvt_pk_f32_fp8((int)a.x, false), d1 = __builtin_amdgcn_cvt_pk_f32_fp8((int)a.x, true);
  f2_t d2 = __builtin_amdgcn_cvt_pk_f32_fp8((int)a.y, false), d3 = __builtin_amdgcn_cvt_pk_f32_fp8((int)a.y, true);
  f2_t d4 = __builtin_amdgcn_cvt_pk_f32_fp8((int)a.z, false), d5 = __builtin_amdgcn_cvt_pk_f32_fp8((int)a.z, true);
  f2_t d6 = __builtin_amdgcn_cvt_pk_f32_fp8((int)a.w, false), d7 = __builtin_amdgcn_cvt_pk_f32_fp8((int)a.w, true);
  float s0 = d0[0] * hf[0], s1 = d0[1] * hf[1];
  s0 += d1[0] * hf[2]; s1 += d1[1] * hf[3];
  s0 += d2[0] * hf[4]; s1 += d2[1] * hf[5];
  s0 += d3[0] * hf[6]; s1 += d3[1] * hf[7];
  s0 += d4[0] * hf[8]; s1 += d4[1] * hf[9];
  s0 += d5[0] * hf[10]; s1 += d5[1] * hf[11];
  s0 += d6[0] * hf[12]; s1 += d6[1] * hf[13];
  s0 += d7[0] * hf[14]; s1 += d7[1] * hf[15];
  return s0 + s1;
}
__device__ __forceinline__ void axpy16f8(float (&acc)[16], float hk, uint4 a) {
  f2_t d0 = __builtin_amdgcn_cvt_pk_f32_fp8((int)a.x, false), d1 = __builtin_amdgcn_cvt_pk_f32_fp8((int)a.x, true);
  f2_t d2 = __builtin_amdgcn_cvt_pk_f32_fp8((int)a.y, false), d3 = __builtin_amdgcn_cvt_pk_f32_fp8((int)a.y, true);
  f2_t d4 = __builtin_amdgcn_cvt_pk_f32_fp8((int)a.z, false), d5 = __builtin_amdgcn_cvt_pk_f32_fp8((int)a.z, true);
  f2_t d6 = __builtin_amdgcn_cvt_pk_f32_fp8((int)a.w, false), d7 = __builtin_amdgcn_cvt_pk_f32_fp8((int)a.w, true);
  acc[0] += hk * d0[0]; acc[1] += hk * d0[1]; acc[2] += hk * d1[0]; acc[3] += hk * d1[1];
  acc[4] += hk * d2[0]; acc[5] += hk * d2[1]; acc[6] += hk * d3[0]; acc[7] += hk * d3[1];
  acc[8] += hk * d4[0]; acc[9] += hk * d4[1]; acc[10] += hk * d5[0]; acc[11] += hk * d5[1];
  acc[12] += hk * d6[0]; acc[13] += hk * d6[1]; acc[14] += hk * d7[0]; acc[15] += hk * d7[1];
}

__device__ void phase_gather(const Params& p, int bid, int nb, char* smem) {
  float* tw = (float*)smem;
  float* ts = tw + 2048;
  float* tg = ts + 2048;
  float* tf = tg + 2048;
  const int tid = threadIdx.x, lane = tid & 63, w = tid >> 6;
  for (int i = tid; i < 2048; i += 256) {
    int b = i >> 10, j = i & 1023;
    tw[i] = p.norm2_w[j] * (1.f + p.mod[b * 6144 + 4 * 1024 + j]);
    ts[i] = p.mod[b * 6144 + 3 * 1024 + j];
    tg[i] = p.mod[b * 6144 + 5 * 1024 + j];
  }
  for (int i = tid; i < 1024; i += 256) tf[i] = p.final_w[i];
  __syncthreads();
  const int e0 = lane * 16;
  const int GW = nb * 4;
  constexpr int PD = 8;
  for (int tok = bid * 4 + w; tok < T; tok += GW) {
    asm volatile("" ::: "memory");
    const int b = tok >> 13;
    const float* xr = p.x1 + (size_t)tok * 1024 + e0;
    float hf[16];
    {
      float4 v[4];
      float ss = 0.f;
#pragma unroll
      for (int i = 0; i < 4; i++) {
        v[i] = *(const float4*)(xr + 4 * i);
        ss += v[i].x * v[i].x + v[i].y * v[i].y + v[i].z * v[i].z + v[i].w * v[i].w;
      }
      ss = wave_sum(ss);
      float rstd = rsqrtf(ss * (1.f / 1024.f) + EPS);
#pragma unroll
      for (int i = 0; i < 4; i++) {
        float4 a = *(const float4*)(tw + b * 1024 + e0 + 4 * i), sh = *(const float4*)(ts + b * 1024 + e0 + 4 * i);
        hf[4 * i + 0] = v[i].x * rstd * a.x + sh.x;
        hf[4 * i + 1] = v[i].y * rstd * a.y + sh.y;
        hf[4 * i + 2] = v[i].z * rstd * a.z + sh.z;
        hf[4 * i + 3] = v[i].w * rstd * a.w + sh.w;
      }
    }
    const int ids0 = p.ids[tok * 128 + lane], ids1 = p.ids[tok * 128 + 64 + lane];
    const int gl = 4 * (lane & 15) + (lane >> 4);
    const int idl0 = p.ids[tok * 128 + gl], idl1 = p.ids[tok * 128 + 64 + gl];
    const float gt0 = p.gates[tok * 128 + gl] * p.sv[idl0], gt1 = p.gates[tok * 128 + 64 + gl] * p.sv[idl1];
    const float us0 = p.su[idl0], us1 = p.su[idl1];
    float acc[16];
#pragma unroll
    for (int i = 0; i < 16; i++) acc[i] = 0.f;
    uint4 bA[PD];
#pragma unroll
    for (int j = 0; j < PD; j++) {
      int id = __builtin_amdgcn_readlane(ids0, j);
      bA[j] = *((const uint4*)(p.ub + (size_t)id * 1024) + lane);
    }
    float hid = 0.f;
#pragma unroll 1
    for (int seg = 0; seg < 4; seg++) {
      const bool isv = seg & 1;
      if (!isv) {
        float hv = 0.f;
#pragma unroll 1
        for (int g = 0; g < 64 / PD; g++) {
          float part[PD];
#pragma unroll
          for (int j = 0; j < PD; j++) {
            part[j] = dot16f8(bA[j], hf);
            int nx = seg * 64 + g * PD + j + PD;
            int nseg = nx >> 6, nk = nx & 63;
            int id = __builtin_amdgcn_readlane((nseg & 2) ? ids1 : ids0, nk);
            const unsigned char* base = (nseg & 1) ? p.vb : p.ub;
            bA[j] = *((const uint4*)(base + (size_t)id * 1024) + lane);
          }
          float r0 = reduce4(part[0], part[1], part[2], part[3]);
          float r1 = reduce4(part[4], part[5], part[6], part[7]);
          hv = ((lane & 15) == 2 * g) ? r0 : hv;
          hv = ((lane & 15) == 2 * g + 1) ? r1 : hv;
        }
        hv *= (seg & 2) ? us1 : us0;
        float gte = (seg & 2) ? gt1 : gt0;
        hid = 0.5f * hv * (1.f + erff(hv * 0.70710678118654752f)) * gte;
      } else {
#pragma unroll 1
        for (int g = 0; g < 64 / PD; g++) {
#pragma unroll
          for (int j = 0; j < PD; j++) {
            int k = g * PD + j;
            float hk = rdlane(hid, (k & 3) * 16 + (k >> 2));
            axpy16f8(acc, hk, bA[j]);
            int nx = (seg * 64 + g * PD + j + PD) & 255;
            int nseg = nx >> 6, nk = nx & 63;
            int id = __builtin_amdgcn_readlane((nseg & 2) ? ids1 : ids0, nk);
            const unsigned char* base = (nseg & 1) ? p.vb : p.ub;
            bA[j] = *((const uint4*)(base + (size_t)id * 1024) + lane);
          }
        }
      }
    }
    asm volatile("" ::: "memory");
    {
      float y[16];
      float ss = 0.f;
#pragma unroll
      for (int i = 0; i < 4; i++) {
        float4 v = *(const float4*)(xr + 4 * i);
        float4 g = *(const float4*)(tg + b * 1024 + e0 + 4 * i);
        y[4 * i] = v.x + g.x * acc[4 * i]; y[4 * i + 1] = v.y + g.y * acc[4 * i + 1];
        y[4 * i + 2] = v.z + g.z * acc[4 * i + 2]; y[4 * i + 3] = v.w + g.w * acc[4 * i + 3];
        ss += y[4 * i] * y[4 * i] + y[4 * i + 1] * y[4 * i + 1] + y[4 * i + 2] * y[4 * i + 2] + y[4 * i + 3] * y[4 * i + 3];
      }
      ss = wave_sum(ss);
      float rstd = rsqrtf(ss * (1.f / 1024.f) + EPS);
      float* orow = p.out + (size_t)tok * 1024 + e0;
#pragma unroll
      for (int i = 0; i < 4; i++) {
        float4 f = *(const float4*)(tf + e0 + 4 * i);
        *(float4*)(orow + 4 * i) = make_float4(y[4 * i] * rstd * f.x, y[4 * i + 1] * rstd * f.y, y[4 * i + 2] * rstd * f.z, y[4 * i + 3] * rstd * f.w);
      }
    }
  }
}

template <int PH>
__device__ __forceinline__ void run_phase(const Params& p, int bid, int nb, char* smem) {
  if (PH == 0) phase0(p, bid, nb, smem);
  if (PH == 1) phase_norm<false>(p, bid, nb, smem);
  if (PH == 2) phase_inproj(p, bid, nb, smem);
  if (PH == 3) phase_mix_a(p, bid, nb, smem);
  if (PH == 4) phase_scan(p, bid, nb);
  if (PH == 5) phase_gla_c(p, bid, nb, smem);
  if (PH == 6) phase_outproj(p, bid, nb, smem);
  if (PH == 7) phase_norm<true>(p, bid, nb, smem);
  if (PH == 8) phase_peer_topk(p, bid, nb, smem);
  if (PH == 9) phase_gather(p, bid, nb, smem);
}

#if MULTI
template <int PH>
__global__ void __launch_bounds__(256, 2) phase_kernel(Params p) {
  __shared__ __attribute__((aligned(16))) char smem[SMEM_BYTES];
  run_phase<PH>(p, blockIdx.x, gridDim.x, smem);
}
#else
#define XB_TMO      128
#define XB_XCNT(j)  (256  + 64 * (j))
#define XB_XSUB(j)  (1280 + 64 * (j))
#define XB_XGEN(j)  (2304 + 64 * (j))
#define XB_TOP      3328
#define XB_TOPGEN   3392
#define XCD_BAR_WORDS 3456
#define XB_SPIN_CAP (1u << 22)
#define LAS __attribute__((address_space(3)))
__device__ __forceinline__ unsigned xb_ld(unsigned* p) { return __hip_atomic_load(p, __ATOMIC_RELAXED, __HIP_MEMORY_SCOPE_AGENT); }
__device__ __forceinline__ unsigned xb_add(unsigned* p, unsigned v) { return __hip_atomic_fetch_add(p, v, __ATOMIC_RELAXED, __HIP_MEMORY_SCOPE_AGENT); }
__device__ __forceinline__ unsigned xb_xcc_id() { return (unsigned)__builtin_amdgcn_s_getreg((3 << 11) | 20) & 0xFu; }
#define XB_SPIN(cond, bar) do { unsigned _sp = 0; while (cond) { __builtin_amdgcn_s_sleep(1); \
    if ((++_sp & 255u) == 0u) { if (xb_ld(&(bar)[XB_TMO])) break; if (_sp > XB_SPIN_CAP) { atomicAdd(&(bar)[XB_TMO], 1u); break; } } } } while (0)
struct XcdBarrier { unsigned* bar; unsigned x; volatile LAS unsigned* st; };
__device__ __forceinline__ XcdBarrier xcd_barrier_post(unsigned* bar, volatile LAS unsigned* st) {
  XcdBarrier b; b.bar = bar; b.x = xb_xcc_id(); b.st = st;
  if (threadIdx.x == 0) (void)xb_add(&bar[XB_XCNT(b.x)], 1u);
  return b;
}
__device__ __forceinline__ void xcd_barrier_complete(unsigned* bar, unsigned x, unsigned& nloc, unsigned& nx) {
  const unsigned G = gridDim.x * gridDim.y * gridDim.z;
  unsigned sum, cnt, mine, sp = 0u;
  for (;;) {
    sum = 0u; cnt = 0u; mine = 0u;
#pragma unroll
    for (unsigned j = 0; j < 16; ++j) { const unsigned c = xb_ld(&bar[XB_XCNT(j)]); sum += c; cnt += (c > 0u) ? 1u : 0u; mine = (j == x) ? c : mine; }
    if (sum == G) break;
    __builtin_amdgcn_s_sleep(1);
    if ((++sp & 255u) == 0u) { if (xb_ld(&bar[XB_TMO])) break; if (sp > XB_SPIN_CAP) { atomicAdd(&bar[XB_TMO], 1u); break; } }
  }
  nloc = mine > 0u ? mine : 1u; nx = cnt > 0u ? cnt : 1u;
}
__device__ __forceinline__ void xcd_barrier(const XcdBarrier& b) {
  asm volatile("s_waitcnt vmcnt(0)" ::: "memory");
  __syncthreads();
  if (threadIdx.x == 0) {
    unsigned* bar = b.bar;
    __builtin_amdgcn_s_waitcnt(0);
    unsigned nloc = b.st[0], nx = b.st[1];
    if (nloc == 0u) { xcd_barrier_complete(bar, b.x, nloc, nx); b.st[0] = nloc; b.st[1] = nx; }
    const unsigned old = xb_add(&bar[XB_XSUB(b.x)], 1u);
    const unsigned gen = old / nloc;
    if (old + 1u == (gen + 1u) * nloc) {
      __builtin_amdgcn_fence(__ATOMIC_RELEASE, "agent");
      asm volatile("s_waitcnt vmcnt(0)" ::: "memory");
      const unsigned og = xb_add(&bar[XB_TOP], 1u);
      const unsigned tg = og / nx;
      if (og + 1u == (tg + 1u) * nx) xb_add(&bar[XB_TOPGEN], 1u);
      else XB_SPIN(xb_ld(&bar[XB_TOPGEN]) == tg, bar);
      __builtin_amdgcn_fence(__ATOMIC_ACQUIRE, "agent");
      xb_add(&bar[XB_XGEN(b.x)], 1u);
      asm volatile("s_waitcnt vmcnt(0)" ::: "memory");
    } else {
      XB_SPIN(xb_ld(&bar[XB_XGEN(b.x)]) == gen, bar);
      __builtin_amdgcn_fence(__ATOMIC_ACQUIRE, "agent");
      asm volatile("s_waitcnt vmcnt(0)" ::: "memory");
    }
  }
  __syncthreads();
}

__global__ void __launch_bounds__(256, 2) fwd_megakernel(Params p) {
  __shared__ __attribute__((aligned(16))) char smem[SMEM_BYTES];
  __shared__ uint4 xb_words;
  const int bid = blockIdx.x, nb = gridDim.x;
  if (p.use_cg) cg::this_grid().sync();
  if (threadIdx.x == 0) xb_words = make_uint4(0u, 0u, 0u, 0u);
  __syncthreads();
  XcdBarrier xb = xcd_barrier_post(p.bar, (volatile LAS unsigned*)&xb_words);
  run_phase<0>(p, bid, nb, smem); xcd_barrier(xb);
#ifdef REP0
  run_phase<0>(p, bid, nb, smem); xcd_barrier(xb);
#endif
  run_phase<1>(p, bid, nb, smem); xcd_barrier(xb);
  run_phase<2>(p, bid, nb, smem); xcd_barrier(xb);
#ifdef REP2
  run_phase<2>(p, bid, nb, smem); xcd_barrier(xb);
#endif
  run_phase<3>(p, bid, nb, smem); xcd_barrier(xb);
#ifdef REP3
  run_phase<3>(p, bid, nb, smem); xcd_barrier(xb);
#endif
  run_phase<4>(p, bid, nb, smem); xcd_barrier(xb);
  run_phase<5>(p, bid, nb, smem); xcd_barrier(xb);
#ifdef REP5
  run_phase<5>(p, bid, nb, smem); xcd_barrier(xb);
#endif
  run_phase<6>(p, bid, nb, smem); xcd_barrier(xb);
#ifdef REP6
  run_phase<6>(p, bid, nb, smem); xcd_barrier(xb);
#endif
  run_phase<7>(p, bid, nb, smem); xcd_barrier(xb);
  run_phase<8>(p, bid, nb, smem); xcd_barrier(xb);
#ifdef REP8
  run_phase<8>(p, bid, nb, smem); xcd_barrier(xb);
#endif
  run_phase<9>(p, bid, nb, smem);
#ifdef REP9
  xcd_barrier(xb); run_phase<9>(p, bid, nb, smem);
#endif
}
#endif

extern "C" void kernel_launch(void* const* d_in, const int* in_sizes, int n_in, void* d_out, int out_size, void* d_ws,
                              size_t ws_size, hipStream_t stream) {
  Params p{};
  p.x = (const float*)d_in[0]; p.c = (const float*)d_in[1]; p.w_ada = (const float*)d_in[2]; p.b_ada = (const float*)d_in[3];
  p.norm1_w = (const float*)d_in[4]; p.w_in = (const float*)d_in[5]; p.sinks = (const float*)d_in[6];
  p.gate_up = (const float*)d_in[7]; p.gate_bias = (const float*)d_in[8]; p.gla_norm_w = (const float*)d_in[9];
  p.w_out = (const float*)d_in[10]; p.norm2_w = (const float*)d_in[11]; p.wq = (const float*)d_in[12];
  p.subkeys = (const float*)d_in[13]; p.pu = (const float*)d_in[14]; p.pv = (const float*)d_in[15];
  p.final_w = (const float*)d_in[16];
  p.out = (float*)d_out;
  char* ws = (char*)d_ws;
  size_t off = 0;
  auto take = [&](size_t bytes) { char* q = ws + off; off += (bytes + 255) & ~(size_t)255; return q; };
  p.bar = (unsigned*)take(16384);
  p.modp = (float*)take(4 * 2 * 6144 * 4);
  p.mod = (float*)take(2 * 6144 * 4);
  p.w_inT = (bf16_t*)take((size_t)NPROJ * 1024 * 2);
  p.w_outT = (bf16_t*)take((size_t)1024 * 1024 * 2);
  p.wqT = (bf16_t*)take((size_t)2048 * 1024 * 2);
  p.skb = (bf16_t*)take((size_t)262144 * 2);
  p.ub = (unsigned char*)take((size_t)16384 * 1024);
  p.vb = (unsigned char*)take((size_t)16384 * 1024);
  p.su = (float*)take(16384 * 4);
  p.sv = (float*)take(16384 * 4);
  p.hA = (bf16_t*)take((size_t)T * 1024 * 2);
  p.proj = (bf16_t*)take((size_t)T * NPROJ * 2);
  p.x1 = (float*)p.proj;
  p.vT = (bf16_t*)take((size_t)2 * 128 * SEQ * 2);
  p.gvT = (bf16_t*)take((size_t)2 * 512 * SEQ * 2);
  p.stateT = (float*)take((size_t)1024 * 8192 * 4);
  p.ids = (int*)p.stateT;
  p.gates = (float*)((char*)p.stateT + (size_t)T * 128 * 4);
  p.gdec = (float*)take((size_t)1024 * 64 * 4);
  if (off > ws_size) { fprintf(stderr, "workspace too small: need %zu have %zu\n", off, ws_size); return; }

#if MULTI
  const int grid = 512;
  phase_kernel<0><<<grid, 256, 0, stream>>>(p);
  phase_kernel<1><<<grid, 256, 0, stream>>>(p);
  phase_kernel<2><<<grid, 256, 0, stream>>>(p);
  phase_kernel<3><<<grid, 256, 0, stream>>>(p);
  phase_kernel<4><<<grid, 256, 0, stream>>>(p);
  phase_kernel<5><<<grid, 256, 0, stream>>>(p);
  phase_kernel<6><<<grid, 256, 0, stream>>>(p);
  phase_kernel<7><<<grid, 256, 0, stream>>>(p);
  phase_kernel<8><<<grid, 256, 0, stream>>>(p);
  phase_kernel<9><<<grid, 256, 0, stream>>>(p);
#else
  static int grid_blocks = 0;
  if (!grid_blocks) {
    int dev = 0, cus = 0, per_cu = 0;
    hipGetDevice(&dev);
    hipDeviceGetAttribute(&cus, hipDeviceAttributeMultiprocessorCount, dev);
    (void)hipOccupancyMaxActiveBlocksPerMultiprocessor(&per_cu, fwd_megakernel, 256, 0);
    per_cu = 2;
    grid_blocks = cus * per_cu;
  }
  (void)hipMemsetAsync(p.bar, 0, 16384, stream);
  void* args[] = {&p};
  hipError_t e = hipLaunchCooperativeKernel((void*)fwd_megakernel, dim3(grid_blocks), dim3(256), args, 0, stream);
  if (e != hipSuccess) fprintf(stderr, "cooperative launch failed: %s (grid %d)\n", hipGetErrorString(e), grid_blocks);
#endif
}
```
